# Optimizing an MI355X kernel written in HIP

```python
import jax
import jax.numpy as jnp
from jax import lax
import numpy as np

D_MODEL = 1024
BATCH = 1
SEQ = 16384
DEPTH = 4

GRID_W = 64
CTX_LEN = 256
N_HEADS = 8
N_KV_HEADS = 2
HEAD_DIM = 64
Q_GROUP = N_HEADS // N_KV_HEADS
Q_W = N_HEADS * HEAD_DIM
KV_W = N_KV_HEADS * HEAD_DIM
ATTN_BLOCK = 128
ROPE_THETA = 10000.0
FNET_GROUPS = 4
FNET_GROUP_DIM = 64
FNET_WIDTH = FNET_GROUPS * FNET_GROUP_DIM
CONV_WIDTH = 256
CONV_KERNEL = 31
SC_WIDTH = 256
SC_KERNEL = 3
N_BRANCHES = 4
D_FF = 2816
N_MOD = 9
EPS = 1e-6
IN_SPLITS = (Q_W, KV_W, KV_W, FNET_WIDTH, 2 * CONV_WIDTH, 3 * SC_WIDTH, N_BRANCHES * D_MODEL)
IN_W = sum(IN_SPLITS)

kernel_name = "hybrid_parallel_branch_diffusion_block"


def rmsnorm(x, g):
    x32 = x.astype(jnp.float32)
    y = x32 * lax.rsqrt(jnp.mean(x32 * x32, axis=-1, keepdims=True) + EPS)
    return (y * g.astype(jnp.float32)).astype(x.dtype)


def layernorm(x, g, b):
    x32 = x.astype(jnp.float32)
    mu = jnp.mean(x32, axis=-1, keepdims=True)
    var = jnp.mean(jnp.square(x32 - mu), axis=-1, keepdims=True)
    y = (x32 - mu) * lax.rsqrt(var + EPS)
    return (y * g.astype(jnp.float32) + b.astype(jnp.float32)).astype(x.dtype)


def split_in(p):
    idx = [int(i) for i in np.cumsum(IN_SPLITS)[:-1]]
    return jnp.split(p, idx, axis=-1)


def axial_rope_tables(n_tokens):
    n_rows = n_tokens // GRID_W
    row = jnp.broadcast_to(jnp.arange(n_rows)[:, None], (n_rows, GRID_W)).reshape(-1)
    col = jnp.broadcast_to(jnp.arange(GRID_W)[None, :], (n_rows, GRID_W)).reshape(-1)
    axis_dim = HEAD_DIM // 2
    inv_freq = ROPE_THETA ** (-jnp.arange(0, axis_dim, 2, dtype=jnp.float32) / axis_dim)
    pos = jnp.stack([row, col], axis=-1).astype(jnp.float32)
    ang = pos[:, :, None] * inv_freq
    return jnp.cos(ang), jnp.sin(ang)


def apply_axial_rope(x, cos, sin):
    B, L, H, _ = x.shape
    xr = x.astype(jnp.float32).reshape(B, L, H, 2, 2, HEAD_DIM // 4)
    x1, x2 = xr[..., 0, :], xr[..., 1, :]
    cs = cos[None, :, None]
    sn = sin[None, :, None]
    out = jnp.stack([x1 * cs - x2 * sn, x1 * sn + x2 * cs], axis=-2)
    return out.reshape(x.shape).astype(x.dtype)


def to_heads(t, n_heads):
    B, L, _ = t.shape
    return t.reshape(B, L, n_heads, HEAD_DIM)


def attend(q, k, v):
    s = jnp.einsum('bqkgd,bskd->bkgqs', q, k).astype(jnp.float32) * (HEAD_DIM ** -0.5)
    p = jax.nn.softmax(s, axis=-1).astype(v.dtype)
    return jnp.einsum('bkgqs,bskd->bqkgd', p, v)


def latent_attention(q, k, v, k_ctx, v_ctx):
    B, L = q.shape[:2]
    keys = jnp.concatenate([k_ctx, k], axis=1)
    vals = jnp.concatenate([v_ctx, v], axis=1)
    n_blk = L // ATTN_BLOCK
    qb = q.reshape(B, n_blk, ATTN_BLOCK, N_KV_HEADS, Q_GROUP, HEAD_DIM).transpose(1, 0, 2, 3, 4, 5)
    ob = lax.map(lambda qq: attend(qq, keys, vals), qb)
    return ob.transpose(1, 0, 2, 3, 4, 5).reshape(B, L, Q_W)


def context_attention(q, k, v):
    B, L = q.shape[:2]
    o = attend(q.reshape(B, L, N_KV_HEADS, Q_GROUP, HEAD_DIM), k, v)
    return o.reshape(B, L, Q_W)


def depthwise_conv(x, w):
    k_w = w.shape[0]
    pad = (k_w - 1) // 2
    return lax.conv_general_dilated(
        x, w[:, None, :].astype(x.dtype), window_strides=(1,), padding=[(pad, pad)],
        dimension_numbers=('NWC', 'WIO', 'NWC'), feature_group_count=x.shape[-1])


def fourier_mix(f):
    B, L, _ = f.shape
    fg = f.astype(jnp.float32).reshape(B, L, FNET_GROUPS, FNET_GROUP_DIM)
    y = jnp.fft.fft2(fg, axes=(1, 3), norm='ortho').real
    return y.reshape(B, L, FNET_WIDTH).astype(f.dtype)


def conformer_conv(a, dw_w, dw_b, ln_g, ln_b):
    a1, a2 = jnp.split(a, 2, axis=-1)
    h = a1 * jax.nn.sigmoid(a2)
    h = depthwise_conv(h, dw_w) + dw_b
    h = layernorm(h, ln_g, ln_b)
    return jax.nn.silu(h)


def short_gated_conv(s, w):
    gb, gc, h = jnp.split(s, 3, axis=-1)
    return gb * depthwise_conv(gc * h, w)


def merge_branches(attn, f, cg, sc, g, lw):
    B, L, _ = attn.shape
    y_a = attn @ lw['w_attn_out']
    y_b = fourier_mix(f) @ lw['w_fnet']
    y_c = conformer_conv(cg, lw['conv_dw_w'], lw['conv_dw_b'], lw['conv_ln_g'], lw['conv_ln_b']) @ lw['w_conv_out']
    y_d = short_gated_conv(sc, lw['sc_conv_w']) @ lw['w_sc_out']
    gates = jax.nn.sigmoid(g + lw['b_gate']).reshape(B, L, N_BRANCHES, D_MODEL)
    merged = gates[:, :, 0] * y_a + gates[:, :, 1] * y_b + gates[:, :, 2] * y_c + gates[:, :, 3] * y_d
    return merged @ lw['w_o']


def modulated_norm(x, mod, slot, g):
    return rmsnorm(x, g) * (1 + mod[:, :, 3 * slot + 1]) + mod[:, :, 3 * slot]


def ffn_half(x, mod, slot, g, w13, w2):
    h = modulated_norm(x, mod, slot, g)
    a, b = jnp.split(h @ w13, 2, axis=-1)
    return x + 0.5 * mod[:, :, 3 * slot + 2] * ((jax.nn.silu(a) * b) @ w2)


def setup_inputs(seed: int = 0) -> dict:
    key = jax.random.key(seed)
    ks = jax.random.split(key, 24)
    nrm = jax.random.normal
    f32 = jnp.float32
    D = D_MODEL
    return {
        'x': nrm(ks[0], (BATCH, SEQ, D), f32),
        'c': nrm(ks[1], (BATCH, D), f32),
        'ctx': nrm(ks[2], (BATCH, CTX_LEN, D), f32),
        'c_ctx': nrm(ks[3], (D,), f32),
        'w_ada': nrm(ks[4], (DEPTH, D, N_MOD * D), f32) * (0.5 * D ** -0.5),
        'b_ada': nrm(ks[5], (DEPTH, N_MOD * D), f32) * 0.01,
        'norm_g': 1.0 + 0.01 * nrm(ks[6], (DEPTH, 3, D), f32),
        'ffn_w13': nrm(ks[7], (DEPTH, 2, D, 2 * D_FF), f32) * D ** -0.5,
        'ffn_w2': nrm(ks[8], (DEPTH, 2, D_FF, D), f32) * D_FF ** -0.5,
        'w_in': nrm(ks[9], (DEPTH, D, IN_W), f32) * D ** -0.5,
        'b_gate': nrm(ks[10], (DEPTH, N_BRANCHES * D), f32) * 0.01,
        'q_norm_g': 1.0 + 0.01 * nrm(ks[11], (DEPTH, HEAD_DIM), f32),
        'k_norm_g': 1.0 + 0.01 * nrm(ks[12], (DEPTH, HEAD_DIM), f32),
        'w_attn_out': nrm(ks[13], (DEPTH, Q_W, D), f32) * Q_W ** -0.5,
        'w_fnet': nrm(ks[14], (DEPTH, FNET_WIDTH, D), f32) * FNET_WIDTH ** -0.5,
        'conv_dw_w': nrm(ks[15], (DEPTH, CONV_KERNEL, CONV_WIDTH), f32) * CONV_KERNEL ** -0.5,
        'conv_dw_b': nrm(ks[16], (DEPTH, CONV_WIDTH), f32) * 0.01,
        'conv_ln_g': 1.0 + 0.01 * nrm(ks[17], (DEPTH, CONV_WIDTH), f32),
        'conv_ln_b': nrm(ks[18], (DEPTH, CONV_WIDTH), f32) * 0.01,
        'w_conv_out': nrm(ks[19], (DEPTH, CONV_WIDTH, D), f32) * CONV_WIDTH ** -0.5,
        'sc_conv_w': nrm(ks[20], (DEPTH, SC_KERNEL, SC_WIDTH), f32) * SC_KERNEL ** -0.5,
        'w_sc_out': nrm(ks[21], (DEPTH, SC_WIDTH, D), f32) * SC_WIDTH ** -0.5,
        'w_o': nrm(ks[22], (DEPTH, D, D), f32) * D ** -0.5,
        'final_norm_g': 1.0 + 0.01 * nrm(ks[23], (D,), f32),
    }


def reference(x, c, ctx, c_ctx, w_ada, b_ada, norm_g, ffn_w13, ffn_w2, w_in, b_gate,
              q_norm_g, k_norm_g, w_attn_out, w_fnet, conv_dw_w, conv_dw_b, conv_ln_g,
              conv_ln_b, w_conv_out, sc_conv_w, w_sc_out, w_o, final_norm_g):
    B, L, D = x.shape
    cos, sin = axial_rope_tables(L)
    cx = ctx
    for l in range(DEPTH):
        last = l == DEPTH - 1
        lw = {
            'w_attn_out': w_attn_out[l], 'w_fnet': w_fnet[l], 'conv_dw_w': conv_dw_w[l],
            'conv_dw_b': conv_dw_b[l], 'conv_ln_g': conv_ln_g[l], 'conv_ln_b': conv_ln_b[l],
            'w_conv_out': w_conv_out[l], 'sc_conv_w': sc_conv_w[l], 'w_sc_out': w_sc_out[l],
            'b_gate': b_gate[l], 'w_o': w_o[l],
        }
        mod_x = (jax.nn.silu(c) @ w_ada[l] + b_ada[l]).reshape(B, 1, N_MOD, D)
        mod_c = (jax.nn.silu(c_ctx) @ w_ada[l] + b_ada[l]).reshape(1, 1, N_MOD, D)

        x = ffn_half(x, mod_x, 0, norm_g[l, 0], ffn_w13[l, 0], ffn_w2[l, 0])
        cx = ffn_half(cx, mod_c, 0, norm_g[l, 0], ffn_w13[l, 0], ffn_w2[l, 0])

        u_x = modulated_norm(x, mod_x, 1, norm_g[l, 1])
        u_c = modulated_norm(cx, mod_c, 1, norm_g[l, 1])
        q_x, k_x, v_x, f_x, cg_x, sc_x, g_x = split_in(u_x @ w_in[l])
        if last:
            k_c, v_c = jnp.split(u_c @ w_in[l, :, Q_W:Q_W + 2 * KV_W], 2, axis=-1)
        else:
            q_c, k_c, v_c, f_c, cg_c, sc_c, g_c = split_in(u_c @ w_in[l])
        k_c = rmsnorm(to_heads(k_c, N_KV_HEADS), k_norm_g[l])
        v_c = to_heads(v_c, N_KV_HEADS)

        qh = apply_axial_rope(rmsnorm(to_heads(q_x, N_HEADS), q_norm_g[l]), cos, sin)
        kh = apply_axial_rope(rmsnorm(to_heads(k_x, N_KV_HEADS), k_norm_g[l]), cos, sin)
        attn_x = latent_attention(qh, kh, to_heads(v_x, N_KV_HEADS), k_c, v_c)
        x = x + mod_x[:, :, 5] * merge_branches(attn_x, f_x, cg_x, sc_x, g_x, lw)

        if not last:
            qc = rmsnorm(to_heads(q_c, N_HEADS), q_norm_g[l])
            attn_c = context_attention(qc, k_c, v_c)
            cx = cx + mod_c[:, :, 5] * merge_branches(attn_c, f_c, cg_c, sc_c, g_c, lw)

        x = ffn_half(x, mod_x, 2, norm_g[l, 2], ffn_w13[l, 1], ffn_w2[l, 1])
        if not last:
            cx = ffn_half(cx, mod_c, 2, norm_g[l, 2], ffn_w13[l, 1], ffn_w2[l, 1])

    return rmsnorm(x, final_norm_g)
```

```cpp
#include <hip/hip_runtime.h>
#include <hip/hip_cooperative_groups.h>
#include <cstdio>
#include <cstdint>
namespace cg = cooperative_groups;

__device__ __forceinline__ int fresh_tid() { int t = (int)threadIdx.x; asm volatile("" : "+v"(t)); return t; }
typedef const __attribute__((address_space(4))) unsigned char* kargp_t;
struct KP {
    kargp_t kp;
    __device__ __forceinline__ const float* in(int i) const { return *(const float* const __attribute__((address_space(4)))*)(kp + 8 * i); }
    __device__ __forceinline__ float* out() const { return *(float* const __attribute__((address_space(4)))*)(kp + 8 * 24); }
    __device__ __forceinline__ unsigned char* ws() const { return *(unsigned char* const __attribute__((address_space(4)))*)(kp + 8 * 25); }
};
__device__ __forceinline__ KP fresh_kp() { KP p; p.kp = (kargp_t)__builtin_amdgcn_kernarg_segment_ptr(); asm volatile("" : "+s"(p.kp)); return p; }
namespace pg8 {
#define PG8_LAS __attribute__((address_space(3)))
typedef unsigned short bf16_t;
typedef _Float16 bf16x8 __attribute__((ext_vector_type(8)));
typedef float f32x4 __attribute__((ext_vector_type(4)));
typedef unsigned u32x4 __attribute__((ext_vector_type(4)));
constexpr int BM = 256, BK = 64, HALF = 128, HTB = HALF * BK * 2  , STAGE_BYTES = 8 * HTB, NXCD = 8, WGM = 8;

__host__ __device__ __forceinline__ int lds_byte(int r, int c) { const int st = (r >> 4) * 2 + (c >> 5), rr = r & 15, cc = c & 31, ob = rr * 64 + cc * 2; return st * 1024 + (ob ^ (((ob >> 9) & 1) << 5)); }
__host__ __device__ __forceinline__ void stage_rc(int b, int& R, int& C) { const int st = b / 1024, sb = b % 1024, swz = sb ^ (((sb >> 9) & 1) << 5); R = (st >> 1) * 16 + swz / 64; C = (st & 1) * 32 + (swz % 64) / 2; }
__host__ __device__ __forceinline__ int perm32(int rho) { const int n = rho >> 4, i = rho & 15; return 8 * (i >> 2) + 4 * n + (i & 3); }

struct Unit { int pm, pn; };
struct Gemm { const bf16_t* A; const bf16_t* Bt; int M, N, K; };

struct StaticOrder {
    int nM, nN, nwg, G, c;
    __host__ __device__ void init(int M, int N, int G_, int c_) { nM = M / BM; nN = N / BM; nwg = nM * nN; G = G_; c = c_; }
    __host__ __device__ bool next(int i, Unit& u) const {
        const long L = (long)i * G + c; if (L >= nwg) return false;
        int wgid = (int)L; { const int q = nwg / NXCD, r = nwg % NXCD, xcd = wgid % NXCD, off = wgid / NXCD; wgid = (xcd < r ? xcd * (q + 1) : r * (q + 1) + (xcd - r) * q) + off; }
        const int nig = WGM * nN, gid = wgid / nig, fm = gid * WGM, gsz = (nM - fm) < WGM ? (nM - fm) : WGM;
        u.pm = fm + ((wgid % nig) % gsz); u.pn = (wgid % nig) / gsz; return true;
    }
    __device__ __forceinline__ void a_ready(const Unit&) const {}
    __device__ __forceinline__ void done(const Unit&) const {}
};
typedef _Float16 h16x2e __attribute__((ext_vector_type(2)));
typedef unsigned u32x2 __attribute__((ext_vector_type(2)));
__device__ __forceinline__ unsigned pk2h(float lo, float hi) { h16x2e v; v.x = (_Float16)lo; v.y = (_Float16)hi; return __builtin_bit_cast(unsigned, v); }
__device__ __forceinline__ float silu_f(float a) { return a * __builtin_amdgcn_rcpf(1.0f + __expf(-a)); }
__device__ __forceinline__ float sigm_f(float a) { return __builtin_amdgcn_rcpf(1.0f + __expf(-a)); }

struct EpiStoreF16 {
    static constexpr bool PERM = true, AFTER_DRAIN = false;
    bf16_t* O; int ldc;
    __device__ __forceinline__ void operator()(const f32x4 (&acc)[2][2][4][2], const Unit& u, int wr, int wc, int fr, int fq) const {
        const int row0 = u.pm * BM + wr * 64 + fr, col0 = u.pn * BM + wc * 32 + 8 * fq;
#pragma unroll
        for (int ai = 0; ai < 2; ++ai)
#pragma unroll
            for (int m = 0; m < 4; ++m) { bf16_t* rowp = O + (size_t)(row0 + ai * HALF + m * 16) * ldc + col0;
#pragma unroll
                for (int bj = 0; bj < 2; ++bj) { const f32x4 v0 = acc[ai][bj][m][0], v1 = acc[ai][bj][m][1];
                    u32x4 w; w.x = pk2h(v0[0], v0[1]); w.y = pk2h(v0[2], v0[3]); w.z = pk2h(v1[0], v1[1]); w.w = pk2h(v1[2], v1[3]);
                    *(u32x4*)(rowp + bj * HALF) = w; } }
    }
};
struct EpiSwiGLU {
    static constexpr bool PERM = true, AFTER_DRAIN = false;
    bf16_t* O; int ldc;
    __device__ __forceinline__ void operator()(const f32x4 (&acc)[2][2][4][2], const Unit& u, int wr, int wc, int fr, int fq) const {
        const int row0 = u.pm * BM + wr * 64 + fr, col0 = u.pn * HALF + wc * 32 + 8 * fq;
#pragma unroll
        for (int ai = 0; ai < 2; ++ai)
#pragma unroll
            for (int m = 0; m < 4; ++m) { bf16_t* rowp = O + (size_t)(row0 + ai * HALF + m * 16) * ldc + col0;
                const f32x4 a0 = acc[ai][0][m][0], a1 = acc[ai][0][m][1], b0 = acc[ai][1][m][0], b1 = acc[ai][1][m][1];
                float r[8];
#pragma unroll
                for (int i = 0; i < 4; ++i) { r[i] = silu_f(a0[i]) * b0[i]; r[4 + i] = silu_f(a1[i]) * b1[i]; }
                u32x4 w; w.x = pk2h(r[0], r[1]); w.y = pk2h(r[2], r[3]); w.z = pk2h(r[4], r[5]); w.w = pk2h(r[6], r[7]);
                *(u32x4*)(rowp) = w; }
    }
};
struct EpiResidual {
    static constexpr bool PERM = false, AFTER_DRAIN = false;
    float* X; const float* sv_lat; const float* sv_ctx; float mul;
    __device__ __forceinline__ void operator()(const f32x4 (&acc)[2][2][4][2], const Unit& u, int wr, int wc, int fr, int fq) const {
        const float* sv = (u.pm == 0) ? sv_ctx : sv_lat;
        const int col0 = u.pn * BM + wc * 32 + 4 * fq;
        f32x4 s[2][2];
#pragma unroll
        for (int bj = 0; bj < 2; ++bj)
#pragma unroll
            for (int n = 0; n < 2; ++n) s[bj][n] = *(const f32x4*)(sv + col0 + bj * HALF + n * 16) * mul;
#pragma unroll
        for (int ai = 0; ai < 2; ++ai)
#pragma unroll
            for (int m = 0; m < 4; ++m) { float* xp = X + (size_t)(u.pm * BM + ai * HALF + wr * 64 + m * 16 + fr) * 1024 + col0;
#pragma unroll
                for (int bj = 0; bj < 2; ++bj)
#pragma unroll
                    for (int n = 0; n < 2; ++n) { f32x4* p = (f32x4*)(xp + bj * HALF + n * 16); *p = *p + s[bj][n] * acc[ai][bj][m][n]; }
                asm volatile("" ::: "memory"); }
    }
};
struct EpiGate {
    static constexpr bool PERM = false, AFTER_DRAIN = false;
    const bf16_t* G; int ldg; const float* bg; float* S32; bf16_t* SH; int first, last;
    __device__ __forceinline__ void operator()(const f32x4 (&acc)[2][2][4][2], const Unit& u, int wr, int wc, int fr, int fq) const {
        const int col0 = u.pn * BM + wc * 32 + 4 * fq;
#pragma unroll
        for (int ai = 0; ai < 2; ++ai)
#pragma unroll
            for (int m = 0; m < 4; ++m) { const size_t row = (size_t)(u.pm * BM + ai * HALF + wr * 64 + m * 16 + fr);
#pragma unroll
                for (int bj = 0; bj < 2; ++bj)
#pragma unroll
                    for (int n = 0; n < 2; ++n) { const int c = col0 + bj * HALF + n * 16;
                        typedef _Float16 h16x4e __attribute__((ext_vector_type(4)));
                        const h16x4e gv = *(const h16x4e*)(G + row * ldg + c); const f32x4 bv = *(const f32x4*)(bg + c);
                        f32x4 v;
#pragma unroll
                        for (int i = 0; i < 4; ++i) v[i] = sigm_f((float)gv[i] + bv[i]) * acc[ai][bj][m][n][i];
                        if (!first) v = v + *(const f32x4*)(S32 + row * 1024 + c);
                        if (last) { u32x2 w; w.x = pk2h(v[0], v[1]); w.y = pk2h(v[2], v[3]); *(u32x2*)(SH + row * 1024 + c) = w; }
                        else *(f32x4*)(S32 + row * 1024 + c) = v; }
                asm volatile("" ::: "memory"); }
    }
};

template <class Epi, class Sched, bool ALIGN_EPI = false, bool SP2 = false>
__device__ __forceinline__ void gemm_phase(PG8_LAS unsigned char* lds, const Gemm g, const Sched& S, const Epi& E) {
    const int tid = fresh_tid(), wid = __builtin_amdgcn_readfirstlane(tid >> 6), lane = tid & 63, wr = wid >> 2, wc = wid & 3, fr = lane & 15, fq = lane >> 4;
    const int K = g.K, nt = K / BK;
    unsigned voffA[2], voffB[2];
#pragma unroll
    for (int i = 0; i < 2; ++i) { int R, C; stage_rc(tid * 16 + i * 8192, R, C); const int Rb = Epi::PERM ? ((R & ~31) + perm32(R & 31)) : R;
        voffA[i] = (unsigned)(R * K + C) * 2u; voffB[i] = (unsigned)(Rb * K + C) * 2u; }
    const size_t kstep = (size_t)(BK * 2);
    const size_t hstep = (size_t)HALF * K * 2;
    const size_t tstep = 2 * hstep;
    const unsigned ldsw = (unsigned)wid * 1024u;
    const int aoff = lds_byte(wr * 64 + fr, fq * 8), boff = lds_byte(wc * 32 + fr, fq * 8);
#define PG8_SA(b, h) (((b) * 2 + (h)) * HTB)
#define PG8_SB(b, h) ((4 + (b) * 2 + (h)) * HTB)
#define PG8_STAGE(bufoff, gbase, voff) do { _Pragma("unroll") for (int _i = 0; _i < 2; ++_i) \
        __builtin_amdgcn_global_load_lds((const unsigned*)((const char*)(gbase) + (voff)[_i]), (PG8_LAS unsigned*)(lds + (bufoff) + ldsw + _i * 8192), 16, 0, 0); } while (0)
#define PG8_LDA(dst, b, h) do { _Pragma("unroll") for (int m = 0; m < 4; ++m) _Pragma("unroll") for (int k = 0; k < 2; ++k) dst[m][k] = *(const PG8_LAS bf16x8*)(lds + PG8_SA(b, h) + aoff + m * 2048 + k * 1024); } while (0)
#define PG8_LDB(dst, b, h) do { _Pragma("unroll") for (int n = 0; n < 2; ++n) _Pragma("unroll") for (int k = 0; k < 2; ++k) dst[n][k] = *(const PG8_LAS bf16x8*)(lds + PG8_SB(b, h) + boff + n * 2048 + k * 1024); } while (0)
#define PG8_MMA(ai, bj, At, Bt) do { __builtin_amdgcn_s_setprio(1); _Pragma("unroll") for (int m = 0; m < 4; ++m) _Pragma("unroll") for (int n = 0; n < 2; ++n) _Pragma("unroll") for (int k = 0; k < 2; ++k) \
        acc[ai][bj][m][n] = __builtin_amdgcn_mfma_f32_16x16x32_f16(Bt[n][k], At[m][k], acc[ai][bj][m][n], 0, 0, 0); __builtin_amdgcn_s_setprio(0); } while (0)
#define PG8_WAIT_V(n) asm volatile("s_waitcnt vmcnt(" #n ")" ::: "memory")
#define PG8_WAIT_L(n) asm volatile("s_waitcnt lgkmcnt(" #n ")" ::: "memory")
#define PG8_BAR __builtin_amdgcn_s_barrier()
#define PG8_SCHED __builtin_amdgcn_sched_barrier(0)
    Unit cur, nxt; int ui = 0;
    if (!S.next(0, cur)) return;
    f32x4 acc[2][2][4][2];
#pragma unroll
    for (int a = 0; a < 2; ++a)
#pragma unroll
        for (int b = 0; b < 2; ++b)
#pragma unroll
            for (int m = 0; m < 4; ++m)
#pragma unroll
                for (int n = 0; n < 2; ++n) acc[a][b][m][n] = (f32x4){0.f, 0.f, 0.f, 0.f};
    bf16x8 At[4][2], B0[2][2], B1[2][2];
    const char* cA = (const char*)g.A + (size_t)cur.pm * tstep; const char* cB = (const char*)g.Bt + (size_t)cur.pn * tstep;
    S.a_ready(cur);
    if constexpr (SP2) {
        PG8_STAGE(PG8_SB(0, 0), cB, voffB); PG8_STAGE(PG8_SB(0, 1), cB + hstep, voffB); PG8_STAGE(PG8_SA(0, 0), cA, voffA); PG8_STAGE(PG8_SA(0, 1), cA + hstep, voffA);
        if (wr == 1) PG8_BAR;
        PG8_WAIT_V(2); PG8_BAR;
        PG8_STAGE(PG8_SB(1, 0), cB + kstep, voffB); PG8_STAGE(PG8_SA(1, 0), cA + kstep, voffA); PG8_STAGE(PG8_SB(1, 1), cB + hstep + kstep, voffB);
        PG8_WAIT_V(6); PG8_BAR;
    } else {
        PG8_STAGE(PG8_SB(0, 0), cB, voffB); PG8_STAGE(PG8_SA(0, 0), cA, voffA); PG8_STAGE(PG8_SB(0, 1), cB + hstep, voffB); PG8_STAGE(PG8_SA(0, 1), cA + hstep, voffA);
        if (wr == 1) PG8_BAR;
        PG8_WAIT_V(4); PG8_BAR;
        PG8_STAGE(PG8_SB(1, 0), cB + kstep, voffB); PG8_STAGE(PG8_SA(1, 0), cA + kstep, voffA); PG8_STAGE(PG8_SB(1, 1), cB + hstep + kstep, voffB);
        PG8_WAIT_V(6); PG8_BAR;
    }
    for (;;) {
        const bool has_next = S.next(ui + 1, nxt);
        const char* nA = has_next ? (const char*)g.A + (size_t)nxt.pm * tstep : cA; const char* nB = has_next ? (const char*)g.Bt + (size_t)nxt.pn * tstep : cB;
        for (int t = 0; t < nt; t += 2) {
            const bool last = (t == nt - 2);
            const char* a1 = cA + (size_t)(t + 1) * kstep;
            const char* a2 = last ? nA : cA + (size_t)(t + 2) * kstep; const char* b2 = last ? nB : cB + (size_t)(t + 2) * kstep;
            const char* a3 = a2 + kstep; const char* b3 = b2 + kstep;
            if (last && has_next) S.a_ready(nxt);
            if constexpr (SP2) {
            PG8_LDB(B0, 0, 0); PG8_LDB(B1, 0, 1); PG8_SCHED; PG8_LDA(At, 0, 0); PG8_STAGE(PG8_SA(1, 1), a1 + hstep, voffA);
            PG8_WAIT_V(8); PG8_WAIT_L(0); PG8_BAR; PG8_MMA(0, 0, At, B0); PG8_MMA(0, 1, At, B1); PG8_BAR; PG8_SCHED;
            PG8_LDA(At, 0, 1); PG8_STAGE(PG8_SB(0, 0), b2, voffB); PG8_STAGE(PG8_SB(0, 1), b2 + hstep, voffB); PG8_STAGE(PG8_SA(0, 0), a2, voffA);
            PG8_WAIT_V(8); PG8_WAIT_L(0); PG8_BAR; PG8_MMA(1, 0, At, B0); PG8_MMA(1, 1, At, B1); PG8_BAR; PG8_SCHED;
            PG8_LDB(B0, 1, 0); PG8_LDB(B1, 1, 1); PG8_SCHED; PG8_LDA(At, 1, 0); PG8_STAGE(PG8_SA(0, 1), a2 + hstep, voffA);
            PG8_WAIT_V(8); PG8_WAIT_L(0); PG8_BAR; PG8_MMA(0, 0, At, B0); PG8_MMA(0, 1, At, B1); PG8_BAR; PG8_SCHED;
            PG8_LDA(At, 1, 1); PG8_STAGE(PG8_SB(1, 0), b3, voffB); PG8_STAGE(PG8_SB(1, 1), b3 + hstep, voffB); PG8_STAGE(PG8_SA(1, 0), a3, voffA);
            PG8_WAIT_V(8); PG8_WAIT_L(0); PG8_BAR; PG8_MMA(1, 0, At, B0); PG8_MMA(1, 1, At, B1); PG8_BAR; PG8_SCHED;
            } else {
            PG8_LDB(B0, 0, 0); PG8_SCHED; PG8_LDA(At, 0, 0); PG8_STAGE(PG8_SA(1, 1), a1 + hstep, voffA);
            PG8_WAIT_L(8); PG8_BAR; PG8_WAIT_L(0); PG8_MMA(0, 0, At, B0); PG8_BAR; PG8_SCHED;
            PG8_LDB(B1, 0, 1); PG8_STAGE(PG8_SB(0, 0), b2, voffB);
            PG8_BAR; PG8_WAIT_L(0); PG8_MMA(0, 1, At, B1); PG8_BAR;
            PG8_LDA(At, 0, 1); PG8_STAGE(PG8_SA(0, 0), a2, voffA);
            PG8_BAR; PG8_WAIT_L(0); PG8_MMA(1, 0, At, B0); PG8_BAR; PG8_SCHED;
            PG8_STAGE(PG8_SB(0, 1), b2 + hstep, voffB);
            PG8_WAIT_V(6); PG8_BAR; PG8_MMA(1, 1, At, B1); PG8_BAR;
            PG8_LDB(B0, 1, 0); PG8_SCHED; PG8_LDA(At, 1, 0); PG8_STAGE(PG8_SA(0, 1), a2 + hstep, voffA);
            PG8_WAIT_L(8); PG8_BAR; PG8_WAIT_L(0); PG8_MMA(0, 0, At, B0); PG8_BAR; PG8_SCHED;
            PG8_LDB(B1, 1, 1); PG8_STAGE(PG8_SB(1, 0), b3, voffB);
            PG8_BAR; PG8_WAIT_L(0); PG8_MMA(0, 1, At, B1); PG8_BAR;
            PG8_LDA(At, 1, 1); PG8_STAGE(PG8_SA(1, 0), a3, voffA);
            PG8_BAR; PG8_WAIT_L(0); PG8_MMA(1, 0, At, B0); PG8_BAR; PG8_SCHED;
            PG8_STAGE(PG8_SB(1, 1), b3 + hstep, voffB);
            PG8_WAIT_V(6); PG8_BAR; PG8_MMA(1, 1, At, B1); PG8_BAR;
            }
        }
        if constexpr (ALIGN_EPI) { if (wr == 0) PG8_BAR; }
        if constexpr (!Epi::AFTER_DRAIN) { E(acc, cur, wr, wc, fr, fq); S.done(cur); }
        if (!has_next) break;
#pragma unroll
        for (int a = 0; a < 2; ++a)
#pragma unroll
            for (int b = 0; b < 2; ++b)
#pragma unroll
                for (int m = 0; m < 4; ++m)
#pragma unroll
                    for (int n = 0; n < 2; ++n) acc[a][b][m][n] = (f32x4){0.f, 0.f, 0.f, 0.f};
        cur = nxt; cA = nA; cB = nB; ++ui;
        if constexpr (ALIGN_EPI) { if (wr == 1) PG8_BAR; }
    }
    PG8_WAIT_V(0);
    if constexpr (!ALIGN_EPI) { if (wr == 0) PG8_BAR; }
    PG8_BAR;
    if constexpr (Epi::AFTER_DRAIN) { E.fused(acc, cur, wr, wc, fr, fq, lds, wid, lane); S.done(cur); }
#undef PG8_SA
#undef PG8_SB
#undef PG8_STAGE
#undef PG8_LDA
#undef PG8_LDB
#undef PG8_MMA
#undef PG8_WAIT_V
#undef PG8_WAIT_L
#undef PG8_BAR
#undef PG8_SCHED
}
}
#include <cmath>
namespace attn_body {
using bf16=_Float16;
using bf16x8=__attribute__((ext_vector_type(8)))short;
using s16x4=__attribute__((ext_vector_type(4)))short;
using f32x16=__attribute__((ext_vector_type(16)))float;
using u32x4=__attribute__((ext_vector_type(4)))unsigned;
constexpr int D=64,QP=512,KP=128;
constexpr int NW=8,QBLK=32,QB=QBLK*NW,KVBLK=64;
constexpr int ATTN_UNIT_ROWS=QB;
__device__ __forceinline__ int crow(int r,int hi){return (r&3)+8*(r>>2)+4*hi;}
#define SBAR() __builtin_amdgcn_sched_barrier(0)
__device__ __forceinline__ void cmask(f32x16&p0,f32x16&p1,int jb,int qrel,int hi){
  const float NEG=-INFINITY; int kb=64*jb+4*hi;
  #pragma unroll
  for(int r=0;r<16;++r){int kv=kb+(r&3)+8*(r>>2); if(kv>qrel)p0[r]=NEG; if(kv+32>qrel)p1[r]=NEG;}
}

constexpr int NSLOT=3, SLOTB=8192;
constexpr int LDS_K=0, LDS_V=NSLOT*SLOTB, LDS_WS=2*NSLOT*SLOTB, LDS_OST=LDS_WS+NW*64*4, LDS_BYTES=LDS_OST+NW*4096;
constexpr float C2=0.125f*1.4426950408889634f;
__device__ __forceinline__ void glds16(const void*gsrc,unsigned lds_dst){unsigned keep;
  asm volatile("s_mov_b32 %0, m0\n\ts_mov_b32 m0, %2\n\ts_nop 0\n\tglobal_load_lds_dwordx4 %1, off\n\ts_mov_b32 m0, %0":"=&s"(keep):"v"(gsrc),"s"(lds_dst):"memory");}
__device__ __forceinline__ float max3f(float a,float b,float c){float r;asm("v_max3_f32 %0, %1, %2, %3":"=v"(r):"v"(a),"v"(b),"v"(c));return r;}
__device__ __forceinline__ float max2f(float a,float b){float r;asm("v_max_f32_e32 %0, %1, %2":"=v"(r):"v"(a),"v"(b));return r;}
__device__ __forceinline__ float fadd_s(float a,float b){float r;asm("v_add_f32_e32 %0, %1, %2":"=v"(r):"v"(a),"v"(b));return r;}
__device__ __forceinline__ float fsub_s(float a,float b){float r;asm("v_sub_f32_e32 %0, %1, %2":"=v"(r):"v"(a),"v"(b));return r;}
typedef _Float16 h16x8_t __attribute__((ext_vector_type(8)));
__device__ __forceinline__ f32x16 mfma32h(bf16x8 a,bf16x8 b,f32x16 c,int,int,int){return __builtin_amdgcn_mfma_f32_32x32x16_f16(__builtin_bit_cast(h16x8_t,a),__builtin_bit_cast(h16x8_t,b),c,0,0,0);}
__device__ __forceinline__ unsigned cvtpk_s(float lo,float hi){return __builtin_bit_cast(unsigned,__builtin_amdgcn_cvt_pkrtz(lo,hi));}
#define WAIT_BAR(N) asm volatile("s_waitcnt vmcnt(" #N ") lgkmcnt(0)\n\ts_barrier":::"memory")

__device__ __forceinline__ void qkt(f32x16&p0,f32x16&p1,const char*Kslot,const bf16x8*qr,const f32x16&negm,int r32,int hi){
  const char*kb=Kslot+hi*1024+r32*16;
  #pragma unroll
  for(int d0=0;d0<4;++d0){
    const bf16x8 b0=*reinterpret_cast<const bf16x8*>(kb+d0*2048);
    const bf16x8 b1=*reinterpret_cast<const bf16x8*>(kb+d0*2048+512);
    if(d0==0){p0=mfma32h(b0,qr[0],negm,0,0,0);p1=mfma32h(b1,qr[0],negm,0,0,0);}
    else{p0=mfma32h(b0,qr[d0],p0,0,0,0);p1=mfma32h(b1,qr[d0],p1,0,0,0);}}
}
typedef __attribute__((address_space(3))) const char* lds_cptr;
typedef short v4i16_t __attribute__((ext_vector_type(4)));
__device__ __forceinline__ void kload8(bf16x8*kf,lds_cptr kp){
  kf[0]=*(const __attribute__((address_space(3))) bf16x8*)(kp);      kf[1]=*(const __attribute__((address_space(3))) bf16x8*)(kp+512);
  kf[2]=*(const __attribute__((address_space(3))) bf16x8*)(kp+2048); kf[3]=*(const __attribute__((address_space(3))) bf16x8*)(kp+2560);
  kf[4]=*(const __attribute__((address_space(3))) bf16x8*)(kp+4096); kf[5]=*(const __attribute__((address_space(3))) bf16x8*)(kp+4608);
  kf[6]=*(const __attribute__((address_space(3))) bf16x8*)(kp+6144); kf[7]=*(const __attribute__((address_space(3))) bf16x8*)(kp+6656);
}
__device__ __forceinline__ void kload2(bf16x8*kf,lds_cptr kp,int j){ kf[2*j]=*(const __attribute__((address_space(3))) bf16x8*)(kp+j*2048); kf[2*j+1]=*(const __attribute__((address_space(3))) bf16x8*)(kp+j*2048+512); }
__device__ __forceinline__ s16x4 vtr(lds_cptr p){ return __builtin_bit_cast(s16x4,__builtin_amdgcn_ds_read_tr16_b64_v4i16((__attribute__((address_space(3))) v4i16_t*)p)); }
__device__ __forceinline__ float rowmax(const f32x16&p0,const f32x16&p1){
  float a=max3f(p0[0],p0[1],p1[0]),b=max3f(p0[2],p0[3],p1[1]);a=max3f(a,p1[2],p1[3]);
  #pragma unroll
  for(int r=4;r<16;r+=4){a=max3f(a,p0[r],p0[r+1]);b=max3f(b,p0[r+2],p0[r+3]);a=max3f(a,p1[r],p1[r+1]);b=max3f(b,p1[r+2],p1[r+3]);}
  const float m=max2f(a,b);
  auto rr=__builtin_amdgcn_permlane32_swap(__float_as_uint(m),__float_as_uint(m),false,false);
  return max2f(__uint_as_float(rr[0]),__uint_as_float(rr[1]));
}
__device__ __forceinline__ void pv(f32x16*o,int vb,bf16x8 pa0,bf16x8 pa1,bf16x8 pa2,bf16x8 pa3){
  #pragma unroll
  for(int d0=0;d0<2;++d0){s16x4 lo[4],hi[4];
    #pragma unroll
    for(int ks=0;ks<4;++ks){
      asm volatile("ds_read_b64_tr_b16 %0,%1 offset:%c2":"=&v"(lo[ks]):"v"(vb),"i"(d0*4096+ks*1024):"memory");
      asm volatile("ds_read_b64_tr_b16 %0,%1 offset:%c2":"=&v"(hi[ks]):"v"(vb),"i"(d0*4096+ks*1024+512):"memory");}
    asm volatile("s_waitcnt lgkmcnt(0)":::"memory");SBAR();
    #define PK(k) (bf16x8){lo[k][0],lo[k][1],lo[k][2],lo[k][3],hi[k][0],hi[k][1],hi[k][2],hi[k][3]}
    o[d0]=mfma32h(pa0,PK(0),o[d0],0,0,0);
    o[d0]=mfma32h(pa1,PK(1),o[d0],0,0,0);
    o[d0]=mfma32h(pa2,PK(2),o[d0],0,0,0);
    o[d0]=mfma32h(pa3,PK(3),o[d0],0,0,0);
    #undef PK
  }
}

#ifndef ATTN_STORE16
#define ATTN_STORE16(p,v) (*(u32x4*)(p)=(v))
#endif
template<int THRL> __device__ __forceinline__ void attn_unit(int h,int qb,int NT,const bf16*Q,const bf16*__restrict__ K,const bf16*__restrict__ V,bf16*O,char*shm){
  const int tid=fresh_tid(),lane=tid&63,r32=lane&31,hi=lane>>5; const int wid=__builtin_amdgcn_readfirstlane(tid>>6);
  const int q0=qb*QB;
  const bf16*Qw=Q+(long)(q0+wid*QBLK)*QP+h*D;
  const bf16*Kh=K+(h>>2)*D,*Vh=V+(h>>2)*D;
  const unsigned lds0=(unsigned)(uintptr_t)shm;
  float*wsf=(float*)(shm+LDS_WS)+wid*64;
  const bf16*ksrc=Kh+(long)lane*KP+wid*8;
  const bf16*vsrc=Vh+(long)(16*(wid&3)+(lane>>2))*KP+(wid>>2)*32+(lane&3)*8;
  const unsigned kdst=lds0+LDS_K+wid*1024, vdst=lds0+LDS_V+wid*1024;
  #define DMA_K(t,slot) glds16(ksrc+(long)(t)*KVBLK*KP,(unsigned)__builtin_amdgcn_readfirstlane(kdst+(slot)))
  #define DMA_V(t,slot) glds16(vsrc+(long)(t)*KVBLK*KP,(unsigned)__builtin_amdgcn_readfirstlane(vdst+(slot)))
  const int vb0=(int)(lds0+LDS_V)+((lane>>4)&1)*32+(lane&3)*8+(4*hi+((lane&15)>>2))*64;
  const char*Kbase=shm+LDS_K; bf16x8 kf[8];
  const lds_cptr shm3=(lds_cptr)shm; const lds_cptr kp0=shm3+LDS_K+hi*1024+r32*16; const lds_cptr vp0=shm3+LDS_V+((lane>>4)&1)*32+(lane&3)*8+(4*hi+((lane&15)>>2))*64;
  DMA_K(0,0);DMA_V(0,0);DMA_K(1,SLOTB);
  bf16x8 qr[4];
  #pragma unroll
  for(int d0=0;d0<4;++d0)qr[d0]=*reinterpret_cast<const bf16x8*>(&Qw[(long)r32*QP+d0*16+hi*8]);
  float mhat=0.f,l_reg=0.f;f32x16 o[2];o[0]=f32x16{};o[1]=f32x16{};f32x16 negm=f32x16{};asm volatile("":"+v"(negm));
  const int qrel=wid*QBLK+r32;
  #define CMASK(P0,P1,t) do{}while(0)
  bool resc=false;
  #define START(P0,P1) do{ const float rm=rowmax(P0,P1); resc=false; \
    { const float dl=rm; mhat=fadd_s(mhat,dl); \
      _Pragma("unroll") for(int r=0;r<16;++r){P0[r]=fsub_s(P0[r],dl);P1[r]=fsub_s(P1[r],dl);} \
      _Pragma("unroll") for(int r=0;r<16;++r)negm[r]=-mhat; asm volatile("":"+v"(negm)); } \
    _Pragma("unroll") for(int r=0;r<16;++r)P0[r]=__builtin_amdgcn_exp2f(P0[r]); }while(0)
  #define RESC() do{ if(resc){ asm volatile("s_waitcnt lgkmcnt(0)":::"memory"); \
      _Pragma("unroll") for(int d_=0;d_<2;++d_) _Pragma("unroll") for(int r=0;r<16;++r)o[d_][r]*=wsf[crow(r,hi)]; } }while(0)
  f32x16 pA0,pA1,pB0,pB1;
  int sl_prev=0,sl_cur=0,sl_next=SLOTB;
  #define ROT() do{sl_prev=sl_cur;sl_cur=sl_next;sl_next=(sl_next==(NSLOT-1)*SLOTB)?0:sl_next+SLOTB;}while(0)
  DMA_K(2,2*SLOTB);
  WAIT_BAR(3);
  qkt(pA0,pA1,Kbase,qr,negm,r32,hi);asm volatile("s_nop 15\n\ts_nop 7":"+v"(pA0),"+v"(pA1));CMASK(pA0,pA1,0);
  START(pA0,pA1);
  _Pragma("unroll") for(int r=0;r<16;++r)pA1[r]=__builtin_amdgcn_exp2f(pA1[r]);
  WAIT_BAR(0);
  DMA_K(3,0);DMA_V(1,SLOTB);
  ROT();
  kload8(kf,kp0+sl_cur);
  WAIT_BAR(2);
  s16x4 vlo[8],vhi[8]; u32x4 pw0,pw1,pw2,pw3;
  #define PKW(P,B) cvtpk_s(P[B],P[B+1])
  #define PAF(k) __builtin_bit_cast(bf16x8,pw##k)
  #define VFR(i) (bf16x8){vlo[i][0],vlo[i][1],vlo[i][2],vlo[i][3],vhi[i][0],vhi[i][1],vhi[i][2],vhi[i][3]}
  #define PIN(x) asm volatile("":"+v"(x))
  #define MX3(a,b,c) __builtin_fmaxf(__builtin_fmaxf((a),(b)),(c))
  #define GAPA(MF,A0,A1,A2,A3,W0,W1,PW) do{ MF; sacc+=A0; sacc+=A1; sacc+=A2; sacc+=A3; PIN(sacc); W0; W1; PIN(PW); SBAR(); }while(0)
  #define EX(v) __builtin_amdgcn_exp2f(v)
  #define GAPB(MF,X,B) do{ MF; X[B]=EX(X[B]); X[B+1]=EX(X[B+1]); X[B+2]=EX(X[B+2]); X[B+3]=EX(X[B+3]); PIN(X); SBAR(); }while(0)
  #define VRD(i) do{ vlo[i]=vtr(vp_+(((i)>>2)*4096+((i)&3)*1024)); vhi[i]=vtr(vp_+(((i)>>2)*4096+((i)&3)*1024+512)); }while(0)
  #define KRD(G,j) do{ if(G){ kload2(kf,kp0+sl_next,j); SBAR(); } }while(0)
  #define STEP(C0,C1,P0,P1,t,GK,GV,GL) do{ SBAR(); \
    const lds_cptr vp_=vp0+sl_prev; \
    VRD(0); SBAR(); float sacc=(P0[0]+P0[1]); \
    GAPA(C0=mfma32h(kf[0],qr[0],negm,0,0,0), P0[2],P0[3],P0[4],P0[5],     pw0[0]=PKW(P0,0), pw0[1]=PKW(P0,2), pw0); \
    VRD(4); SBAR(); GAPA(C1=mfma32h(kf[1],qr[0],negm,0,0,0), P0[6],P0[7],P0[8],P0[9],     pw0[2]=PKW(P0,4), pw0[3]=PKW(P0,6), pw0); \
    VRD(1); SBAR(); GAPA(C0=mfma32h(kf[2],qr[1],C0,0,0,0),   P0[10],P0[11],P0[12],P0[13], pw1[0]=PKW(P0,8), pw1[1]=PKW(P0,10), pw1); \
    VRD(5); SBAR(); GAPA(C1=mfma32h(kf[3],qr[1],C1,0,0,0),   P0[14],P0[15],P1[0],P1[1],   pw1[2]=PKW(P0,12),pw1[3]=PKW(P0,14), pw1); \
    VRD(2); SBAR(); GAPA(C0=mfma32h(kf[4],qr[2],C0,0,0,0),   P1[2],P1[3],P1[4],P1[5],     pw2[0]=PKW(P1,0), pw2[1]=PKW(P1,2), pw2); \
    VRD(6); SBAR(); GAPA(C1=mfma32h(kf[5],qr[2],C1,0,0,0),   P1[6],P1[7],P1[8],P1[9],     pw2[2]=PKW(P1,4), pw2[3]=PKW(P1,6), pw2); \
    VRD(3); SBAR(); GAPA(C0=mfma32h(kf[6],qr[3],C0,0,0,0),   P1[10],P1[11],P1[12],P1[13], pw3[0]=PKW(P1,8), pw3[1]=PKW(P1,10), pw3); \
    VRD(7); SBAR(); GAPA(C1=mfma32h(kf[7],qr[3],C1,0,0,0),   P1[14],P1[15],0.f,0.f,       pw3[2]=PKW(P1,12),pw3[3]=PKW(P1,14), pw3); \
    l_reg+=sacc; \
    if(GK){DMA_K((t)+3,sl_cur);} if(GV){DMA_V((t)+1,sl_next);} \
    CMASK(C0,C1,t); \
    { float a=MX3(C0[0],C0[1],C1[0]),b=MX3(C0[2],C0[3],C1[1]); a=MX3(a,C1[2],C1[3]); \
      _Pragma("unroll") for(int r=4;r<16;r+=4){a=MX3(a,C0[r],C0[r+1]);b=MX3(b,C0[r+2],C0[r+3]);a=MX3(a,C1[r],C1[r+1]);b=MX3(b,C1[r+2],C1[r+3]);} \
      float rm=__builtin_fmaxf(a,b); { auto rr=__builtin_amdgcn_permlane32_swap(__float_as_uint(rm),__float_as_uint(rm),false,false); rm=__builtin_fmaxf(__uint_as_float(rr[0]),__uint_as_float(rr[1])); } \
      resc=false; \
      if(__builtin_expect(__any(rm>(float)THRL),0)){ const float dl=__builtin_fmaxf(rm,0.f); mhat+=dl; \
        _Pragma("unroll") for(int r=0;r<16;++r){C0[r]-=dl;C1[r]-=dl;} \
        _Pragma("unroll") for(int r=0;r<16;++r)negm[r]=-mhat; asm volatile("":"+v"(negm)); \
        const float f=__builtin_amdgcn_exp2f(-dl); l_reg*=f; if(hi==0)wsf[r32]=f; resc=true; } } \
    SBAR(); \
    GAPB(o[0]=mfma32h(PAF(0),VFR(0),o[0],0,0,0), C0,0); \
    GAPB(o[1]=mfma32h(PAF(0),VFR(4),o[1],0,0,0), C0,4); \
    KRD(GL,0); GAPB(o[0]=mfma32h(PAF(1),VFR(1),o[0],0,0,0), C0,8); \
    KRD(GL,1); GAPB(o[1]=mfma32h(PAF(1),VFR(5),o[1],0,0,0), C0,12); \
    KRD(GL,2); GAPB(o[0]=mfma32h(PAF(2),VFR(2),o[0],0,0,0), C1,0); \
    KRD(GL,3); GAPB(o[1]=mfma32h(PAF(2),VFR(6),o[1],0,0,0), C1,4); \
    GAPB(o[0]=mfma32h(PAF(3),VFR(3),o[0],0,0,0), C1,8); \
    GAPB(o[1]=mfma32h(PAF(3),VFR(7),o[1],0,0,0), C1,12); \
    }while(0)
  int t=1;
  #undef CMASK
  #define CMASK(P0,P1,t) do{}while(0)
  for(;t+5<NT;t+=2){
    STEP(pB0,pB1,pA0,pA1,t,true,true,true);     WAIT_BAR(2); RESC(); ROT();
    STEP(pA0,pA1,pB0,pB1,t+1,true,true,true);   WAIT_BAR(2); RESC(); ROT();
  }
  #undef CMASK
  #define CMASK(P0,P1,t) do{}while(0)
  #define ENDW(tt) do{ if((tt)+3<NT){WAIT_BAR(2);} else if((tt)+2<NT){WAIT_BAR(1);} else {WAIT_BAR(0);} }while(0)
  for(;t+1<NT;t+=2){
    STEP(pB0,pB1,pA0,pA1,t,(t+3<NT),(t+1<NT),(t+1<NT));       ENDW(t);   RESC(); ROT();
    STEP(pA0,pA1,pB0,pB1,t+1,(t+4<NT),(t+2<NT),(t+2<NT));     ENDW(t+1); RESC(); ROT();
  }
  STEP(pB0,pB1,pA0,pA1,NT-1,false,false,false); RESC();
  { float sacc=pB0[0]+pB0[1]; _Pragma("unroll") for(int r=2;r<16;++r)sacc+=pB0[r]; _Pragma("unroll") for(int r=0;r<16;++r)sacc+=pB1[r]; l_reg+=sacc;
    pw0=(u32x4){PKW(pB0,0),PKW(pB0,2),PKW(pB0,4),PKW(pB0,6)};pw1=(u32x4){PKW(pB0,8),PKW(pB0,10),PKW(pB0,12),PKW(pB0,14)};pw2=(u32x4){PKW(pB1,0),PKW(pB1,2),PKW(pB1,4),PKW(pB1,6)};pw3=(u32x4){PKW(pB1,8),PKW(pB1,10),PKW(pB1,12),PKW(pB1,14)};
    SBAR(); pv(o,vb0+sl_cur,PAF(0),PAF(1),PAF(2),PAF(3)); }
  #undef PKW
  #undef PAF
  #undef VFR
  #undef PIN
  #undef MX3
  #undef GAPA
  #undef GAPB
  #undef EX
  #undef VRD
  #undef KRD
  #undef STEP
  #undef ENDW
  {auto rr=__builtin_amdgcn_permlane32_swap(__float_as_uint(l_reg),__float_as_uint(l_reg),false,false);l_reg=__uint_as_float(rr[0])+__uint_as_float(rr[1]);}
  if(hi==0)wsf[32+r32]=l_reg;asm volatile("s_waitcnt lgkmcnt(0)":::"memory");
  float rli[16];
  #pragma unroll
  for(int r=0;r<16;++r)rli[r]=__builtin_amdgcn_rcpf(wsf[32+crow(r,hi)]);
  bf16*Ow=O+(long)(q0+wid*QBLK)*QP+h*D;
  { bf16*stg=(bf16*)(shm+LDS_OST)+wid*2048;
    #pragma unroll
    for(int r=0;r<16;++r){const int orow=crow(r,hi);
      #pragma unroll
      for(int d0=0;d0<2;++d0)stg[orow*64+d0*32+r32]=(_Float16)(o[d0][r]*rli[r]);}
    asm volatile("s_waitcnt lgkmcnt(0)":::"memory");
    #pragma unroll
    for(int i=0;i<4;++i){const int row=i*8+(lane>>3),ch=lane&7; const u32x4 v=*(const u32x4*)(stg+row*64+ch*8); ATTN_STORE16(Ow+(long)row*QP+ch*8,v);} }
  asm volatile("s_waitcnt lgkmcnt(0)\n\ts_barrier":::"memory");
  #undef DMA_K
  #undef DMA_V
  #undef CMASK
  #undef START
  #undef RESC
  #undef ROT
}
constexpr int ATTN_LDS_BYTES=LDS_BYTES;
#undef SBAR
#undef WAIT_BAR
}
#define LAS __attribute__((address_space(3)))
typedef _Float16 f16;
typedef _Float16 h16x8 __attribute__((ext_vector_type(8)));
typedef _Float16 h16x4 __attribute__((ext_vector_type(4)));
typedef float f32x4 __attribute__((ext_vector_type(4)));
typedef unsigned u32x4 __attribute__((ext_vector_type(4)));
typedef unsigned u32x2 __attribute__((ext_vector_type(2)));
using pg8::pk2h; using pg8::silu_f; using pg8::sigm_f;

constexpr int NWAVES = 8, NTHR = 512;
constexpr int DMODEL = 1024, SEQ = 16384, CTX = 256, T = SEQ + CTX, DEPTH = 4, DFF = 2816, INW = 6400, NMOD = 9;
constexpr int C_Q = 0, C_K = 512, C_V = 640, C_F = 768, C_CG = 1024, C_SC = 1536, C_G = 2304;
constexpr float EPS = 1e-6f;
constexpr float QSCALE = 0.125f * 1.4426950408889634f;
enum { I_X = 0, I_C, I_CTX, I_CCTX, I_WADA, I_BADA, I_NORMG, I_W13, I_W2, I_WIN, I_BGATE, I_QNG, I_KNG, I_WAO, I_WFN, I_CDW, I_CDB, I_CLG, I_CLB, I_WCO, I_SCW, I_WSO, I_WO, I_FNG, N_IN };

constexpr size_t MiB = 1u << 20;
constexpr size_t WS_MOD = 1 * MiB;
constexpr size_t WS_D1 = 2 * MiB;
constexpr size_t WS_D2 = WS_D1 + 65536;
constexpr size_t WS_DC = WS_D2 + 131072;
constexpr size_t WS_W = 4 * MiB;
constexpr size_t W13_E = (size_t)2 * DFF * DMODEL;
constexpr size_t W2_E = (size_t)DMODEL * DFF;
constexpr size_t OFF_W13 = 0, OFF_W2 = OFF_W13 + 2 * W13_E, OFF_WIN = OFF_W2 + 2 * W2_E, OFF_WA = OFF_WIN + (size_t)INW * DMODEL,
                 OFF_WF = OFF_WA + 1024 * 512, OFF_WC = OFF_WF + 1024 * 512, OFF_WS = OFF_WC + 1024 * 256, OFF_WO = OFF_WS + 1024 * 256, W_TOTAL_E = OFF_WO + 1024 * 1024;
constexpr size_t WS_X = 56 * MiB;
constexpr size_t WS_H = 122 * MiB;
constexpr size_t WS_MH = 155 * MiB;
constexpr size_t WS_WINB = 188 * MiB;
constexpr size_t WS_M32 = 392 * MiB;
constexpr size_t WS_QB = 458 * MiB;
constexpr size_t WS_AO = 475 * MiB;
constexpr size_t WS_FO = 492 * MiB;
constexpr size_t WS_KB = 509 * MiB;
constexpr size_t WS_VB = 514 * MiB;
constexpr size_t WS_CV = 519 * MiB;
constexpr size_t WS_SCB = 528 * MiB;
constexpr size_t WS_AP = 537 * MiB;
constexpr size_t WS_END = 554 * MiB;
static_assert(WS_W + W_TOTAL_E * 2 <= WS_X && WS_X + (size_t)T * 1024 * 4 <= WS_H && WS_H + (size_t)T * 2048 <= WS_MH && WS_MH + (size_t)T * 2048 <= WS_WINB &&
              WS_WINB + (size_t)T * INW * 2 <= WS_M32 && WS_M32 + (size_t)T * 4096 <= WS_QB && WS_QB + (size_t)T * 1024 <= WS_AO && WS_AO + (size_t)T * 1024 <= WS_FO &&
              WS_FO + (size_t)T * 1024 <= WS_KB && WS_KB + (size_t)T * 256 <= WS_VB && WS_VB + (size_t)T * 256 <= WS_CV && WS_CV + (size_t)T * 512 <= WS_SCB &&
              WS_SCB + (size_t)T * 512 <= WS_AP && WS_AP + 16 * MiB <= WS_END, "d_ws map");
constexpr int LDS_BYTES = 147456;
constexpr int LDS_TAB = 143360;

struct Args { const float* in[N_IN]; float* out; unsigned char* ws; };

__device__ __forceinline__ void sincos_turns(float t, float* sn, float* cs) { *sn = __builtin_amdgcn_sinf(t); *cs = __builtin_amdgcn_cosf(t); }
__device__ __forceinline__ float wave_sum(float v) {
#pragma unroll
    for (int o = 1; o < 64; o <<= 1) v += __shfl_xor(v, o);
    return v;
}

__device__ __forceinline__ void transpose_item(const float* W, int K, int N, f16* WT, bool swz, LAS float* scr, int item, int lane) {
    const int nblk = N / 32, kb = item / nblk, nb = item % nblk, k0 = 64 * kb, n0 = 32 * nb;
#pragma unroll 8
    for (int i = 0; i < 32; ++i) { const int kk = 2 * i + (lane >> 5); scr[kk * 33 + (lane & 31)] = W[(size_t)(k0 + kk) * N + n0 + (lane & 31)]; }
    asm volatile("s_waitcnt lgkmcnt(0)" ::: "memory");
    int r0 = n0;
    if (swz) { const int blk = n0 >> 7, within = n0 & 127; r0 = (blk < 22) ? (256 * blk + within) : (256 * (blk - 22) + 128 + within); }
    const int c = lane & 7;
#pragma unroll
    for (int j = 0; j < 4; ++j) { const int n = (lane >> 3) + 8 * j; const LAS float* s = scr + (8 * c) * 33 + n;
        u32x4 o; o.x = pk2h(s[0 * 33], s[1 * 33]); o.y = pk2h(s[2 * 33], s[3 * 33]); o.z = pk2h(s[4 * 33], s[5 * 33]); o.w = pk2h(s[6 * 33], s[7 * 33]);
        *(u32x4*)(WT + (size_t)(r0 + n) * K + k0 + 8 * c) = o; }
    asm volatile("s_waitcnt lgkmcnt(0)" ::: "memory");
}
__device__ __forceinline__ void convert_weights(const KP& a, int l, LAS unsigned char* lds, int gw, int NGW, int wave, int lane) {
    LAS float* scr = (LAS float*)(lds + wave * 16384);
    f16* WB = (f16*)(a.ws() + WS_W);
    constexpr int IT13 = 16 * 176, IT2 = 44 * 32, ITIN = 16 * 200, ITA = 8 * 32, ITC = 4 * 32, ITO = 16 * 32;
    constexpr int NITEMS = 2 * IT13 + 2 * IT2 + ITIN + ITA + 2 * ITC + ITO;
    for (int it = gw; it < NITEMS; it += NGW) {
        int r = it;
        if (r < 2 * IT13) { const int s = r / IT13; transpose_item(a.in(I_W13) + (size_t)(l * 2 + s) * DMODEL * 2 * DFF, DMODEL, 2 * DFF, WB + OFF_W13 + s * W13_E, true, scr, r % IT13, lane); continue; } r -= 2 * IT13;
        if (r < 2 * IT2) { const int s = r / IT2; transpose_item(a.in(I_W2) + (size_t)(l * 2 + s) * DFF * DMODEL, DFF, DMODEL, WB + OFF_W2 + s * W2_E, false, scr, r % IT2, lane); continue; } r -= 2 * IT2;
        if (r < ITIN) { transpose_item(a.in(I_WIN) + (size_t)l * DMODEL * INW, DMODEL, INW, WB + OFF_WIN, false, scr, r, lane); continue; } r -= ITIN;
        if (r < ITA) { transpose_item(a.in(I_WAO) + (size_t)l * 512 * 1024, 512, 1024, WB + OFF_WA, false, scr, r, lane); continue; } r -= ITA;
        if (r < ITC) { transpose_item(a.in(I_WCO) + (size_t)l * 256 * 1024, 256, 1024, WB + OFF_WC, false, scr, r, lane); continue; } r -= ITC;
        if (r < ITC) { transpose_item(a.in(I_WSO) + (size_t)l * 256 * 1024, 256, 1024, WB + OFF_WS, false, scr, r, lane); continue; } r -= ITC;
        transpose_item(a.in(I_WO) + (size_t)l * 1024 * 1024, 1024, 1024, WB + OFF_WO, false, scr, r, lane);
    }
    const LAS float* ctab = (const LAS float*)(lds + LDS_TAB); const LAS float* stab = ctab + 64;
    const float* wf = a.in(I_WFN) + (size_t)l * 256 * 1024;
    const int gt = blockIdx.x * NTHR + fresh_tid(), GT = gridDim.x * NTHR;
    for (int idx = gt; idx < 65536; idx += GT) {
        const int o = idx & 1023, rest = idx >> 10, j8 = rest & 7, g = (rest >> 3) & 3, part = rest >> 5;
        float acc[8];
#pragma unroll
        for (int i = 0; i < 8; ++i) acc[i] = 0.f;
        const LAS float* tab = part ? stab : ctab;
        for (int m = 0; m < 64; ++m) { const float wv = wf[(size_t)(g * 64 + m) * 1024 + o];
#pragma unroll
            for (int i = 0; i < 8; ++i) acc[i] += tab[(m * (j8 * 8 + i)) & 63] * wv; }
        u32x4 w; w.x = pk2h(acc[0] * 0.125f, acc[1] * 0.125f); w.y = pk2h(acc[2] * 0.125f, acc[3] * 0.125f); w.z = pk2h(acc[4] * 0.125f, acc[5] * 0.125f); w.w = pk2h(acc[6] * 0.125f, acc[7] * 0.125f);
        *(u32x4*)(WB + OFF_WF + (size_t)o * 512 + part * 256 + g * 64 + j8 * 8) = w;
    }
}
__device__ __forceinline__ void phase0(const KP& a, LAS unsigned char* lds, int gw, int NGW, int wave, int lane) {
    const int tid = fresh_tid();
    {
        LAS float* sl = (LAS float*)lds; LAS float* sc = sl + 1024; LAS float* red = sl + 2048;
        float* MOD = (float*)(a.ws() + WS_MOD);
        bool have = false;
        for (int u = blockIdx.x; u < DEPTH * 36; u += gridDim.x) {
            if (!have) { for (int k = tid; k < 1024; k += NTHR) { sl[k] = silu_f(a.in(I_C)[k]); sc[k] = silu_f(a.in(I_CCTX)[k]); } have = true; __syncthreads(); }
            const int l = u / 36, strip = u % 36;
            const float* wp = a.in(I_WADA) + ((size_t)l * 1024 + wave * 128) * 9216 + strip * 256 + 4 * lane;
            f32x4 a0 = {0.f, 0.f, 0.f, 0.f}, a1 = {0.f, 0.f, 0.f, 0.f};
#pragma unroll 8
            for (int k = 0; k < 128; ++k) { const f32x4 wv = *(const f32x4*)(wp + (size_t)k * 9216); a0 += sl[wave * 128 + k] * wv; a1 += sc[wave * 128 + k] * wv; }
            *(LAS f32x4*)(red + (wave * 2 + 0) * 256 + 4 * lane) = a0; *(LAS f32x4*)(red + (wave * 2 + 1) * 256 + 4 * lane) = a1;
            __syncthreads();
            { const int s = tid >> 8, c = tid & 255; float v = a.in(I_BADA)[l * 9216 + strip * 256 + c];
#pragma unroll
              for (int w = 0; w < 8; ++w) v += red[(w * 2 + s) * 256 + c];
              MOD[(size_t)(l * 2 + s) * 9216 + strip * 256 + c] = v; }
            __syncthreads();
        }
        __syncthreads();
    }
    const int gt = blockIdx.x * NTHR + tid, GT = gridDim.x * NTHR;
    { f16* D1 = (f16*)(a.ws() + WS_D1); f16* D2 = (f16*)(a.ws() + WS_D2); f16* DC = (f16*)(a.ws() + WS_DC);
      const float s128 = 0.08838834764831845f;
      for (int i = gt; i < 32768 + 65536 + 131072; i += GT) {
          float sn, cs;
          if (i < 32768) { const int r = i >> 7, n1 = i & 127, k1 = r & 127; sincos_turns((float)((k1 * n1) & 127) * (1.0f / 128.0f), &sn, &cs); D1[i] = (f16)((r < 128 ? cs : -sn) * s128); }
          else if (i < 32768 + 65536) { const int ii = i - 32768, r = ii >> 8, kk = ii & 255, k2 = r & 127, n2 = kk >> 1, p = kk & 1; sincos_turns((float)((k2 * n2) & 127) * (1.0f / 128.0f), &sn, &cs);
              const float v = (r < 128) ? (p ? sn : cs) : (p ? cs : -sn); D2[ii] = (f16)(v * s128); }
          else { const int ii = i - 32768 - 65536, h = ii >> 16, r = (ii >> 8) & 255, n = ii & 255, rt = r >> 7, k = 128 * h + (r & 127); sincos_turns((float)((k * n) & 255) * (1.0f / 256.0f), &sn, &cs);
              DC[ii] = (f16)((rt ? -sn : cs) * 0.0625f); }
      } }
    { const f32x4* s0 = (const f32x4*)a.in(I_CTX); const f32x4* s1 = (const f32x4*)a.in(I_X); f32x4* X = (f32x4*)(a.ws() + WS_X);
      for (int i = gt; i < T * 256; i += GT) X[i] = (i < CTX * 256) ? s0[i] : s1[i - CTX * 256]; }
    convert_weights(a, 0, lds, gw, NGW, wave, lane);
}

__device__ __forceinline__ void norm_phase(const KP& a, int l, int slot, int gw, int NGW, int lane) {
    const float* X = (const float*)(a.ws() + WS_X); f16* H = (f16*)(a.ws() + WS_H);
    const float* g = a.in(I_NORMG) + (size_t)(l * 3 + slot) * 1024; const float* MOD = (const float*)(a.ws() + WS_MOD);
    for (int r = gw; r < T; r += NGW) {
        const float* md = MOD + (size_t)(l * 2 + (r < CTX ? 1 : 0)) * 9216; const float* shift = md + (3 * slot) * 1024; const float* scale = md + (3 * slot + 1) * 1024;
        const f32x4* xr = (const f32x4*)(X + (size_t)r * 1024) + lane;
        f32x4 v[4]; float ss = 0.f;
#pragma unroll
        for (int j = 0; j < 4; ++j) { v[j] = xr[64 * j]; ss += (v[j].x * v[j].x + v[j].y * v[j].y) + (v[j].z * v[j].z + v[j].w * v[j].w); }
        const float rstd = 1.0f / sqrtf(wave_sum(ss) * (1.0f / 1024.0f) + EPS);
        u32x2* o8 = (u32x2*)(H + (size_t)r * 1024) + lane;
#pragma unroll
        for (int j = 0; j < 4; ++j) { const int c = 4 * lane + 256 * j; const f32x4 gg = *(const f32x4*)(g + c), sc = *(const f32x4*)(scale + c), sh = *(const f32x4*)(shift + c);
            const f32x4 o = (v[j] * rstd) * gg * (sc + 1.0f) + sh; u32x2 w; w.x = pk2h(o.x, o.y); w.y = pk2h(o.z, o.w); o8[64 * j] = w; }
    }
}
__device__ __forceinline__ void final_norm(const KP& a, int gw, int NGW, int lane) {
    const float* X = (const float*)(a.ws() + WS_X) + (size_t)CTX * 1024; const float* g = a.in(I_FNG);
    for (int r = gw; r < SEQ; r += NGW) {
        const f32x4* xr = (const f32x4*)(X + (size_t)r * 1024) + lane;
        f32x4 v[4]; float ss = 0.f;
#pragma unroll
        for (int j = 0; j < 4; ++j) { v[j] = xr[64 * j]; ss += (v[j].x * v[j].x + v[j].y * v[j].y) + (v[j].z * v[j].z + v[j].w * v[j].w); }
        const float rstd = 1.0f / sqrtf(wave_sum(ss) * (1.0f / 1024.0f) + EPS);
        f32x4* o = (f32x4*)(a.out() + (size_t)r * 1024) + lane;
#pragma unroll
        for (int j = 0; j < 4; ++j) o[64 * j] = (v[j] * rstd) * *(const f32x4*)(g + 4 * lane + 256 * j);
    }
}

__device__ __forceinline__ void qkv_prep(const KP& a, int l, int gw, int NGW, int lane) {
    const f16* WINB = (const f16*)(a.ws() + WS_WINB); f16* QB = (f16*)(a.ws() + WS_QB); f16* KB = (f16*)(a.ws() + WS_KB); f16* VB = (f16*)(a.ws() + WS_VB);
    const int j = lane & 7;
    float gq[8], gk[8], invf[8];
#pragma unroll
    for (int i = 0; i < 8; ++i) { gq[i] = a.in(I_QNG)[l * 64 + j * 8 + i]; gk[i] = a.in(I_KNG)[l * 64 + j * 8 + i];
        invf[i] = exp2f(-(float)(8 * (j & 1) + i) * (13.287712379549449f / 16.0f)); }
    const bool p1 = (j >> 1) & 1;
    for (int r = gw; r < T; r += NGW) {
        const f16* wrow = WINB + (size_t)r * INW;
        float cs[8], sn[8];
        const bool lat = r >= CTX;
        if (lat) { const int n = r - CTX; const float pos = (float)((j >> 2) ? (n & 63) : (n >> 6));
#pragma unroll
            for (int i = 0; i < 8; ++i) { const float ang = pos * invf[i]; sincos_turns(ang * 0.15915494309189535f, &sn[i], &cs[i]); } }
        else {
#pragma unroll
            for (int i = 0; i < 8; ++i) { cs[i] = 1.f; sn[i] = 0.f; } }
        { const h16x8 qv = *(const h16x8*)(wrow + C_Q + lane * 8); float x[8]; float ss = 0.f;
#pragma unroll
          for (int i = 0; i < 8; ++i) { x[i] = (float)qv[i]; ss += x[i] * x[i]; }
          ss += __shfl_xor(ss, 1); ss += __shfl_xor(ss, 2); ss += __shfl_xor(ss, 4);
          const float rs = 1.0f / sqrtf(ss * (1.0f / 64.0f) + EPS);
          float y[8];
#pragma unroll
          for (int i = 0; i < 8; ++i) { x[i] = x[i] * rs * gq[i]; }
#pragma unroll
          for (int i = 0; i < 8; ++i) { const float xp = __shfl_xor(x[i], 2); y[i] = p1 ? (xp * sn[i] + x[i] * cs[i]) : (x[i] * cs[i] - xp * sn[i]); y[i] *= QSCALE; }
          u32x4 w; w.x = pk2h(y[0], y[1]); w.y = pk2h(y[2], y[3]); w.z = pk2h(y[4], y[5]); w.w = pk2h(y[6], y[7]);
          *(u32x4*)(QB + (size_t)r * 512 + lane * 8) = w; }
        { const int lk = lane & 15; const h16x8 kv = *(const h16x8*)(wrow + C_K + lk * 8); float x[8]; float ss = 0.f;
#pragma unroll
          for (int i = 0; i < 8; ++i) { x[i] = (float)kv[i]; ss += x[i] * x[i]; }
          ss += __shfl_xor(ss, 1); ss += __shfl_xor(ss, 2); ss += __shfl_xor(ss, 4);
          const float rs = 1.0f / sqrtf(ss * (1.0f / 64.0f) + EPS);
          float y[8];
#pragma unroll
          for (int i = 0; i < 8; ++i) { x[i] = x[i] * rs * gk[i]; }
#pragma unroll
          for (int i = 0; i < 8; ++i) { const float xp = __shfl_xor(x[i], 2); y[i] = p1 ? (xp * sn[i] + x[i] * cs[i]) : (x[i] * cs[i] - xp * sn[i]); }
          u32x4 w; w.x = pk2h(y[0], y[1]); w.y = pk2h(y[2], y[3]); w.z = pk2h(y[4], y[5]); w.w = pk2h(y[6], y[7]);
          if (lane < 16) *(u32x4*)(KB + (size_t)r * 128 + lane * 8) = w;
          else if (lane < 32) *(u32x4*)(VB + (size_t)r * 128 + (lane - 16) * 8) = *(const u32x4*)(wrow + C_V + (lane - 16) * 8); }
    }
}
__device__ __forceinline__ void conv_unit(const KP& a, int l, int u, LAS unsigned char* lds, int wave, int lane) {
    const int tid = fresh_tid();
    const f16* WINB = (const f16*)(a.ws() + WS_WINB); f16* CV = (f16*)(a.ws() + WS_CV); f16* SCB = (f16*)(a.ws() + WS_SCB);
    const int seq0 = (u < 4) ? 0 : CTX, seq1 = (u < 4) ? CTX : T, r0 = (u < 4) ? 64 * u : CTX + 64 * (u - 4);
    LAS f16* tile = (LAS f16*)lds;
    LAS float* co = (LAS float*)(lds + 49152);
    for (int idx = tid; idx < 94 * 32; idx += NTHR) { const int lr = idx >> 5, c8 = idx & 31, r = r0 - 15 + lr;
        h16x8 o;
#pragma unroll
        for (int i = 0; i < 8; ++i) o[i] = (f16)0.f;
        if (r >= seq0 && r < seq1) { const h16x8 a1 = *(const h16x8*)(WINB + (size_t)r * INW + C_CG + c8 * 8), a2 = *(const h16x8*)(WINB + (size_t)r * INW + C_CG + 256 + c8 * 8);
#pragma unroll
            for (int i = 0; i < 8; ++i) o[i] = (f16)((float)a1[i] * sigm_f((float)a2[i])); }
        *(LAS h16x8*)(tile + lr * 256 + c8 * 8) = o; }
    __syncthreads();
    { const int c = tid & 255, half = tid >> 8; float w[31];
#pragma unroll
      for (int t = 0; t < 31; ++t) w[t] = a.in(I_CDW)[(size_t)(l * 31 + t) * 256 + c];
      const float bias = a.in(I_CDB)[l * 256 + c];
#pragma unroll 2
      for (int o = 0; o < 32; ++o) { float acc = bias; const LAS f16* tp = tile + (half * 32 + o) * 256 + c;
#pragma unroll
          for (int t = 0; t < 31; ++t) acc += (float)tp[t * 256] * w[t];
          co[(half * 32 + o) * 256 + c] = acc; } }
    __syncthreads();
    { const f32x4 lg = *(const f32x4*)(a.in(I_CLG) + l * 256 + 4 * lane), lb = *(const f32x4*)(a.in(I_CLB) + l * 256 + 4 * lane);
#pragma unroll 1
      for (int tt = 0; tt < 8; ++tt) { const int tok = wave * 8 + tt; const f32x4 v = *(const LAS f32x4*)(co + tok * 256 + 4 * lane);
          const float mean = wave_sum((v.x + v.y) + (v.z + v.w)) * (1.0f / 256.0f); const f32x4 d = v - mean;
          const float var = wave_sum((d.x * d.x + d.y * d.y) + (d.z * d.z + d.w * d.w)) * (1.0f / 256.0f); const float rstd = 1.0f / sqrtf(var + EPS);
          f32x4 y = d * rstd * lg + lb; y.x = silu_f(y.x); y.y = silu_f(y.y); y.z = silu_f(y.z); y.w = silu_f(y.w);
          u32x2 w; w.x = pk2h(y.x, y.y); w.y = pk2h(y.z, y.w); *(u32x2*)(CV + (size_t)(r0 + tok) * 256 + 4 * lane) = w; } }
    for (int idx = tid; idx < 64 * 32; idx += NTHR) { const int lr = idx >> 5, c8 = idx & 31, r = r0 + lr; float acc[8];
#pragma unroll
        for (int i = 0; i < 8; ++i) acc[i] = 0.f;
#pragma unroll
        for (int t = 0; t < 3; ++t) { const int rr = r + t - 1; if (rr >= seq0 && rr < seq1) {
            const h16x8 gc = *(const h16x8*)(WINB + (size_t)rr * INW + C_SC + 256 + c8 * 8), hh = *(const h16x8*)(WINB + (size_t)rr * INW + C_SC + 512 + c8 * 8);
            const float* wp = a.in(I_SCW) + (size_t)(l * 3 + t) * 256 + c8 * 8;
#pragma unroll
            for (int i = 0; i < 8; ++i) acc[i] += (float)gc[i] * (float)hh[i] * wp[i]; } }
        const h16x8 gb = *(const h16x8*)(WINB + (size_t)r * INW + C_SC + c8 * 8);
        u32x4 w; w.x = pk2h((float)gb[0] * acc[0], (float)gb[1] * acc[1]); w.y = pk2h((float)gb[2] * acc[2], (float)gb[3] * acc[3]);
        w.z = pk2h((float)gb[4] * acc[4], (float)gb[5] * acc[5]); w.w = pk2h((float)gb[6] * acc[6], (float)gb[7] * acc[7]);
        *(u32x4*)(SCB + (size_t)r * 256 + c8 * 8) = w; }
    __syncthreads();
}
template <int K, class Epi>
__device__ __forceinline__ void dft_unit(LAS unsigned char* lds, const f16* gsrc, size_t rstride, const f16* Dm, const Epi& E) {
    constexpr int LPB = 516;
    const int tid = fresh_tid(), lane = tid & 63, wave = tid >> 6, fr = lane & 15, fq = lane >> 4;
    for (int i = tid; i < K * 32; i += NTHR) { const int row = i >> 5, pc = i & 31; const u32x4 v = *(const u32x4*)(gsrc + (size_t)row * rstride + pc * 8);
        LAS unsigned* d = (LAS unsigned*)(lds + row * LPB + pc * 16); d[0] = v.x; d[1] = v.y; d[2] = v.z; d[3] = v.w; }
    __syncthreads();
    const int cbase = wave * 32;
    h16x8 df[2][K / 32];
#pragma unroll
    for (int ct = 0; ct < 2; ++ct)
#pragma unroll
        for (int ks = 0; ks < K / 32; ++ks)
#pragma unroll
            for (int e = 0; e < 8; ++e) df[ct][ks][e] = *(const LAS f16*)(lds + (ks * 32 + fq * 8 + e) * LPB + (cbase + ct * 16 + fr) * 2);
#pragma unroll 1
    for (int j = 0; j < 8; ++j) {
        f32x4 acc[2][2];
#pragma unroll
        for (int rt = 0; rt < 2; ++rt)
#pragma unroll
            for (int ct = 0; ct < 2; ++ct) acc[rt][ct] = (f32x4){0.f, 0.f, 0.f, 0.f};
#pragma unroll
        for (int rt = 0; rt < 2; ++rt)
#pragma unroll
            for (int ks = 0; ks < K / 32; ++ks) { const h16x8 dm = *(const h16x8*)(Dm + (size_t)(rt * 128 + j * 16 + fr) * K + ks * 32 + fq * 8);
#pragma unroll
                for (int ct = 0; ct < 2; ++ct) acc[rt][ct] = __builtin_amdgcn_mfma_f32_16x16x32_f16(df[ct][ks], dm, acc[rt][ct], 0, 0, 0); }
#pragma unroll
        for (int ct = 0; ct < 2; ++ct) E(j * 16 + fr, cbase + ct * 16 + 4 * fq, acc[0][ct], acc[1][ct]);
    }
    __syncthreads();
}
__device__ __forceinline__ void st4h(f16* p, f32x4 v) { u32x2 w; w.x = pk2h(v.x, v.y); w.y = pk2h(v.z, v.w); *(u32x2*)p = w; }
struct EpiB1 { f16* AP; int n2;
    __device__ __forceinline__ void operator()(int k1, int c, f32x4 re, f32x4 im) const {
        float sn, cs; sincos_turns((float)((k1 * n2) & 16383) * (1.0f / 16384.0f), &sn, &cs);
        const f32x4 ar = re * cs + im * sn, ai = im * cs - re * sn;
        f16* p = AP + ((size_t)(k1 * 128 + n2) * 2) * 256 + c; st4h(p, ar); st4h(p + 256, ai); } };
struct EpiB2 { f16* FO; int k1;
    __device__ __forceinline__ void operator()(int k2, int c, f32x4 re, f32x4 im) const {
        f16* p = FO + (size_t)(CTX + k1 + 128 * k2) * 512 + c; st4h(p, re); st4h(p + 256, im); } };
struct EpiDC { f16* FO; int h;
    __device__ __forceinline__ void operator()(int kk, int c, f32x4 re, f32x4 im) const {
        f16* p = FO + (size_t)(128 * h + kk) * 512 + c; st4h(p, re); st4h(p + 256, im); } };

template <class Epi> __device__ __forceinline__ void run_gemm(LAS unsigned char* lds, const f16* A, const f16* Bt, int M, int N, int K, const Epi& E) {
    pg8::Gemm g{(const pg8::bf16_t*)A, (const pg8::bf16_t*)Bt, M, N, K}; pg8::StaticOrder S; S.init(M, N, (int)gridDim.x, (int)blockIdx.x);
    pg8::gemm_phase<Epi, pg8::StaticOrder, true, true>(lds, g, S, E);
}

#define FRESH() const KP a = fresh_kp(); const int tid = fresh_tid(); const int lane = tid & 63; const int wave = __builtin_amdgcn_readfirstlane(tid >> 6); \
    const int gw = bx * NWAVES + wave; unsigned char* const ws = a.ws(); (void)lane; (void)gw; (void)ws
__global__ void __launch_bounds__(NTHR, 2) fwd_megakernel(Args a_unused) {
    extern __shared__ __attribute__((aligned(16))) unsigned char lds_raw[];
    cg::grid_group grid = cg::this_grid();
    LAS unsigned char* lds = (LAS unsigned char*)lds_raw;
    const int G = gridDim.x, bx = blockIdx.x;
    const int vcu = (G % 8 == 0) ? (bx % 8) * (G / 8) + bx / 8 : bx;
    const int NGW = G * NWAVES;
    {
        FRESH();
        if (tid < 64) { float sn, cs; sincos_turns((float)tid * (1.0f / 64.0f), &sn, &cs); LAS float* ctab = (LAS float*)(lds + LDS_TAB); ctab[tid] = cs; ctab[64 + tid] = sn; }
        __syncthreads();
#ifndef NO_P0
        phase0(a, lds, gw, NGW, wave, lane);
#endif
    }
    grid.sync();

#pragma unroll 1
    for (int l = 0; l < DEPTH; ++l) {
#pragma unroll 1
        for (int half = 0; half < 2; ++half) {
            const int slot = 2 * half;
            {
                FRESH();
                if (half == 0 && l > 0) convert_weights(a, l, lds, gw, NGW, wave, lane);
                norm_phase(a, l, slot, gw, NGW, lane);
            }
            grid.sync();
#ifndef NO_G1
            {
                FRESH();
                pg8::EpiSwiGLU E{(pg8::bf16_t*)(ws + WS_WINB), DFF};
                run_gemm(lds, (const f16*)(ws + WS_H), (const f16*)(ws + WS_W) + OFF_W13 + half * W13_E, T, 2 * DFF, DMODEL, E);
            }
#endif
            grid.sync();
#ifndef NO_G2
            {
                FRESH();
                const float* MOD = (const float*)(ws + WS_MOD);
                pg8::EpiResidual E{(float*)(ws + WS_X), MOD + (size_t)(l * 2 + 0) * 9216 + (3 * slot + 2) * 1024, MOD + (size_t)(l * 2 + 1) * 9216 + (3 * slot + 2) * 1024, 0.5f};
                run_gemm(lds, (const f16*)(ws + WS_WINB), (const f16*)(ws + WS_W) + OFF_W2 + half * W2_E, T, DMODEL, DFF, E);
            }
#endif
            grid.sync();
            if (half == 1) break;
            {
                FRESH();
                norm_phase(a, l, 1, gw, NGW, lane);
            }
            grid.sync();
#ifndef NO_G3
            {
                FRESH();
                pg8::EpiStoreF16 E{(pg8::bf16_t*)(ws + WS_WINB), INW};
                run_gemm(lds, (const f16*)(ws + WS_H), (const f16*)(ws + WS_W) + OFF_WIN, T, INW, DMODEL, E);
            }
#endif
            grid.sync();
#pragma unroll 1
            for (int u = bx; u < 260 + 128 + 2; u += G) {
                FRESH();
                const f16* WINB = (const f16*)(ws + WS_WINB);
#ifndef NO_CONV
                if (u < 260) conv_unit(a, l, u, lds, wave, lane); else
#endif
#ifndef NO_DFT
                if (u < 388) { const int n2 = u - 260; EpiB1 E{(f16*)(ws + WS_AP), n2}; dft_unit<128>(lds, WINB + (size_t)(CTX + n2) * INW + C_F, (size_t)128 * INW, (const f16*)(ws + WS_D1), E); }
                else { const int h = u - 388; EpiDC E{(f16*)(ws + WS_FO), h}; dft_unit<256>(lds, WINB + C_F, (size_t)INW, (const f16*)(ws + WS_DC) + (size_t)h * 65536, E); }
#endif
                {}
            }
#ifndef NO_QKV
            {
                FRESH();
                qkv_prep(a, l, gw, NGW, lane);
            }
#endif
            grid.sync();
#pragma unroll 1
            for (int idx = vcu; idx < 512 + 8 + 128; idx += G) {
                FRESH();
                const attn_body::bf16* QB = (const attn_body::bf16*)(ws + WS_QB); const attn_body::bf16* KB = (const attn_body::bf16*)(ws + WS_KB); const attn_body::bf16* VB = (const attn_body::bf16*)(ws + WS_VB);
                attn_body::bf16* AO = (attn_body::bf16*)(ws + WS_AO);
#ifndef NO_ATTN
                if (idx < 512) { const int v = idx & 255; attn_body::attn_unit<8>(v >> 5, 1 + 2 * (v & 31) + (idx >> 8), T / 64, QB, KB, VB, AO, (char*)lds_raw); }
                else if (idx < 520) { attn_body::attn_unit<8>(idx - 512, 0, CTX / 64, QB, KB, VB, AO, (char*)lds_raw); }
                else
#endif
#ifndef NO_DFT2
                { const int k1 = idx - 520; EpiB2 E{(f16*)(ws + WS_FO), k1}; dft_unit<256>(lds, (const f16*)(ws + WS_AP) + (size_t)k1 * 65536, (size_t)256, (const f16*)(ws + WS_D2), E); }
#endif
                {}
            }
            grid.sync();
#ifndef NO_G4
#pragma unroll 1
            for (int b = 0; b < 4; ++b) {
                FRESH();
                const f16* Ab = (const f16*)(ws + ((b == 0) ? WS_AO : (b == 1) ? WS_FO : (b == 2) ? WS_CV : WS_SCB));
                const f16* Wb = (const f16*)(ws + WS_W) + ((b == 0) ? OFF_WA : (b == 1) ? OFF_WF : (b == 2) ? OFF_WC : OFF_WS);
                const int Kb = (b < 2) ? 512 : 256;
                pg8::EpiGate E{(const pg8::bf16_t*)(ws + WS_WINB) + C_G + b * 1024, INW, a.in(I_BGATE) + (size_t)l * 4096 + b * 1024, (float*)(ws + WS_M32), (pg8::bf16_t*)(ws + WS_MH), b == 0, b == 3};
                run_gemm(lds, Ab, Wb, T, DMODEL, Kb, E);
            }
#endif
            grid.sync();
#ifndef NO_G5
            {
                FRESH();
                const float* MOD = (const float*)(ws + WS_MOD);
                pg8::EpiResidual E{(float*)(ws + WS_X), MOD + (size_t)(l * 2 + 0) * 9216 + 5 * 1024, MOD + (size_t)(l * 2 + 1) * 9216 + 5 * 1024, 1.0f};
                run_gemm(lds, (const f16*)(ws + WS_MH), (const f16*)(ws + WS_W) + OFF_WO, T, DMODEL, DMODEL, E);
            }
#endif
            grid.sync();
        }
    }
    {
        FRESH();
        final_norm(a, gw, NGW, lane);
    }
}

extern "C" void kernel_launch(void* const* d_in, const int* in_sizes, int n_in, void* d_out, int out_size, void* d_ws, size_t ws_size, hipStream_t stream) {
    static int grid = 0;
    if (grid == 0) {
        if (n_in != N_IN || out_size != SEQ * DMODEL || ws_size < WS_END) { fprintf(stderr, "kernel_launch: unexpected shapes (n_in %d out %d ws %zu)\n", n_in, out_size, ws_size); grid = -1; return; }
        int dev = 0, cus = 0, per_cu = 0;
        if (hipGetDevice(&dev) != hipSuccess || hipDeviceGetAttribute(&cus, hipDeviceAttributeMultiprocessorCount, dev) != hipSuccess) { grid = -1; return; }
        if (hipFuncSetAttribute((const void*)fwd_megakernel, hipFuncAttributeMaxDynamicSharedMemorySize, LDS_BYTES) != hipSuccess) { fprintf(stderr, "kernel_launch: hipFuncSetAttribute failed\n"); grid = -1; return; }
        if (hipOccupancyMaxActiveBlocksPerMultiprocessor(&per_cu, (const void*)fwd_megakernel, NTHR, LDS_BYTES) != hipSuccess || per_cu < 1) { fprintf(stderr, "kernel_launch: occupancy query says %d\n", per_cu); per_cu = 1; }
        (void)hipGetLastError();
        grid = cus * per_cu;
    }
    if (grid < 0) return;
    Args a{};
    for (int i = 0; i < N_IN; ++i) a.in[i] = (const float*)d_in[i];
    a.out = (float*)d_out; a.ws = (unsigned char*)d_ws;
    void* args[] = {&a};
    hipError_t e = hipLaunchCooperativeKernel((const void*)fwd_megakernel, dim3(grid), dim3(NTHR), args, LDS_BYTES, stream);
    if (e != hipSuccess) fprintf(stderr, "kernel_launch: cooperative launch failed: %s (grid %d)\n", hipGetErrorString(e), grid);
}
```

```cpp
#include <hip/hip_runtime.h>
#include <hip/hip_cooperative_groups.h>
#include <cstdio>
#include <cstdint>
namespace cg = cooperative_groups;

__device__ __forceinline__ int fresh_tid() { int t = (int)threadIdx.x; asm volatile("" : "+v"(t)); return t; }
typedef const __attribute__((address_space(4))) unsigned char* kargp_t;
struct KP {
    kargp_t kp;
    __device__ __forceinline__ const float* in(int i) const { return *(const float* const __attribute__((address_space(4)))*)(kp + 8 * i); }
    __device__ __forceinline__ float* out() const { return *(float* const __attribute__((address_space(4)))*)(kp + 8 * 24); }
    __device__ __forceinline__ unsigned char* ws() const { return *(unsigned char* const __attribute__((address_space(4)))*)(kp + 8 * 25); }
};
__device__ __forceinline__ KP fresh_kp() { KP p; p.kp = (kargp_t)__builtin_amdgcn_kernarg_segment_ptr(); asm volatile("" : "+s"(p.kp)); return p; }
namespace pg8 {
#define PG8_LAS __attribute__((address_space(3)))
typedef unsigned short bf16_t;
typedef _Float16 bf16x8 __attribute__((ext_vector_type(8)));
typedef float f32x4 __attribute__((ext_vector_type(4)));
typedef unsigned u32x4 __attribute__((ext_vector_type(4)));
constexpr int BM = 256, BK = 64, HALF = 128, HTB = HALF * BK * 2  , STAGE_BYTES = 8 * HTB, NXCD = 8, WGM = 8;

__host__ __device__ __forceinline__ int lds_byte(int r, int c) { const int st = (r >> 4) * 2 + (c >> 5), rr = r & 15, cc = c & 31, ob = rr * 64 + cc * 2; return st * 1024 + (ob ^ (((ob >> 9) & 1) << 5)); }
__host__ __device__ __forceinline__ void stage_rc(int b, int& R, int& C) { const int st = b / 1024, sb = b % 1024, swz = sb ^ (((sb >> 9) & 1) << 5); R = (st >> 1) * 16 + swz / 64; C = (st & 1) * 32 + (swz % 64) / 2; }
__host__ __device__ __forceinline__ int perm32(int rho) { const int n = rho >> 4, i = rho & 15; return 8 * (i >> 2) + 4 * n + (i & 3); }

struct Unit { int pm, pn; };
struct Gemm { const bf16_t* A; const bf16_t* Bt; int M, N, K; };

struct StaticOrder {
    int nM, nN, nwg, G, c;
    __host__ __device__ void init(int M, int N, int G_, int c_) { nM = M / BM; nN = N / BM; nwg = nM * nN; G = G_; c = c_; }
    __host__ __device__ bool next(int i, Unit& u) const {
        const long L = (long)i * G + c; if (L >= nwg) return false;
        int wgid = (int)L; { const int q = nwg / NXCD, r = nwg % NXCD, xcd = wgid % NXCD, off = wgid / NXCD; wgid = (xcd < r ? xcd * (q + 1) : r * (q + 1) + (xcd - r) * q) + off; }
        const int nig = WGM * nN, gid = wgid / nig, fm = gid * WGM, gsz = (nM - fm) < WGM ? (nM - fm) : WGM;
        u.pm = fm + ((wgid % nig) % gsz); u.pn = (wgid % nig) / gsz; return true;
    }
    __device__ __forceinline__ void a_ready(const Unit&) const {}
    __device__ __forceinline__ void done(const Unit&) const {}
};
typedef _Float16 h16x2e __attribute__((ext_vector_type(2)));
typedef unsigned u32x2 __attribute__((ext_vector_type(2)));
__device__ __forceinline__ unsigned pk2h(float lo, float hi) { h16x2e v; v.x = (_Float16)lo; v.y = (_Float16)hi; return __builtin_bit_cast(unsigned, v); }
__device__ __forceinline__ float silu_f(float a) { return a * __builtin_amdgcn_rcpf(1.0f + __expf(-a)); }
__device__ __forceinline__ float sigm_f(float a) { return __builtin_amdgcn_rcpf(1.0f + __expf(-a)); }

struct EpiStoreF16 {
    static constexpr bool PERM = true, AFTER_DRAIN = false;
    bf16_t* O; int ldc;
    __device__ __forceinline__ void operator()(const f32x4 (&acc)[2][2][4][2], const Unit& u, int wr, int wc, int fr, int fq) const {
        const int row0 = u.pm * BM + wr * 64 + fr, col0 = u.pn * BM + wc * 32 + 8 * fq;
#pragma unroll
        for (int ai = 0; ai < 2; ++ai)
#pragma unroll
            for (int m = 0; m < 4; ++m) { bf16_t* rowp = O + (size_t)(row0 + ai * HALF + m * 16) * ldc + col0;
#pragma unroll
                for (int bj = 0; bj < 2; ++bj) { const f32x4 v0 = acc[ai][bj][m][0], v1 = acc[ai][bj][m][1];
                    u32x4 w; w.x = pk2h(v0[0], v0[1]); w.y = pk2h(v0[2], v0[3]); w.z = pk2h(v1[0], v1[1]); w.w = pk2h(v1[2], v1[3]);
                    *(u32x4*)(rowp + bj * HALF) = w; } }
    }
};
struct EpiSwiGLU {
    static constexpr bool PERM = true, AFTER_DRAIN = false;
    bf16_t* O; int ldc;
    __device__ __forceinline__ void operator()(const f32x4 (&acc)[2][2][4][2], const Unit& u, int wr, int wc, int fr, int fq) const {
        const int row0 = u.pm * BM + wr * 64 + fr, col0 = u.pn * HALF + wc * 32 + 8 * fq;
#pragma unroll
        for (int ai = 0; ai < 2; ++ai)
#pragma unroll
            for (int m = 0; m < 4; ++m) { bf16_t* rowp = O + (size_t)(row0 + ai * HALF + m * 16) * ldc + col0;
                const f32x4 a0 = acc[ai][0][m][0], a1 = acc[ai][0][m][1], b0 = acc[ai][1][m][0], b1 = acc[ai][1][m][1];
                float r[8];
#pragma unroll
                for (int i = 0; i < 4; ++i) { r[i] = silu_f(a0[i]) * b0[i]; r[4 + i] = silu_f(a1[i]) * b1[i]; }
                u32x4 w; w.x = pk2h(r[0], r[1]); w.y = pk2h(r[2], r[3]); w.z = pk2h(r[4], r[5]); w.w = pk2h(r[6], r[7]);
                *(u32x4*)(rowp) = w; }
    }
};
struct EpiResidual {
    static constexpr bool PERM = false, AFTER_DRAIN = false;
    float* X; const float* sv_lat; const float* sv_ctx; float mul;
    __device__ __forceinline__ void operator()(const f32x4 (&acc)[2][2][4][2], const Unit& u, int wr, int wc, int fr, int fq) const {
        const float* sv = (u.pm == 0) ? sv_ctx : sv_lat;
        const int col0 = u.pn * BM + wc * 32 + 4 * fq;
        f32x4 s[2][2];
#pragma unroll
        for (int bj = 0; bj < 2; ++bj)
#pragma unroll
            for (int n = 0; n < 2; ++n) s[bj][n] = *(const f32x4*)(sv + col0 + bj * HALF + n * 16) * mul;
#pragma unroll
        for (int ai = 0; ai < 2; ++ai)
#pragma unroll
            for (int m = 0; m < 4; ++m) { float* xp = X + (size_t)(u.pm * BM + ai * HALF + wr * 64 + m * 16 + fr) * 1024 + col0;
#pragma unroll
                for (int bj = 0; bj < 2; ++bj)
#pragma unroll
                    for (int n = 0; n < 2; ++n) { f32x4* p = (f32x4*)(xp + bj * HALF + n * 16); *p = *p + s[bj][n] * acc[ai][bj][m][n]; }
                asm volatile("" ::: "memory"); }
    }
};
struct EpiGate {
    static constexpr bool PERM = false, AFTER_DRAIN = false;
    const bf16_t* G; int ldg; const float* bg; float* S32; bf16_t* SH; int first, last;
    __device__ __forceinline__ void operator()(const f32x4 (&acc)[2][2][4][2], const Unit& u, int wr, int wc, int fr, int fq) const {
        const int col0 = u.pn * BM + wc * 32 + 4 * fq;
#pragma unroll
        for (int ai = 0; ai < 2; ++ai)
#pragma unroll
            for (int m = 0; m < 4; ++m) { const size_t row = (size_t)(u.pm * BM + ai * HALF + wr * 64 + m * 16 + fr);
#pragma unroll
                for (int bj = 0; bj < 2; ++bj)
#pragma unroll
                    for (int n = 0; n < 2; ++n) { const int c = col0 + bj * HALF + n * 16;
                        typedef _Float16 h16x4e __attribute__((ext_vector_type(4)));
                        const h16x4e gv = *(const h16x4e*)(G + row * ldg + c); const f32x4 bv = *(const f32x4*)(bg + c);
                        f32x4 v;
#pragma unroll
                        for (int i = 0; i < 4; ++i) v[i] = sigm_f((float)gv[i] + bv[i]) * acc[ai][bj][m][n][i];
                        if (!first) v = v + *(const f32x4*)(S32 + row * 1024 + c);
                        if (last) { u32x2 w; w.x = pk2h(v[0], v[1]); w.y = pk2h(v[2], v[3]); *(u32x2*)(SH + row * 1024 + c) = w; }
                        else *(f32x4*)(S32 + row * 1024 + c) = v; }
                asm volatile("" ::: "memory"); }
    }
};

template <class Epi, class Sched, bool ALIGN_EPI = false, bool SP2 = false>
__device__ __forceinline__ void gemm_phase(PG8_LAS unsigned char* lds, const Gemm g, const Sched& S, const Epi& E) {
    const int tid = fresh_tid(), wid = __builtin_amdgcn_readfirstlane(tid >> 6), lane = tid & 63, wr = wid >> 2, wc = wid & 3, fr = lane & 15, fq = lane >> 4;
    const int K = g.K, nt = K / BK;
    unsigned voffA[2], voffB[2];
#pragma unroll
    for (int i = 0; i < 2; ++i) { int R, C; stage_rc(tid * 16 + i * 8192, R, C); const int Rb = Epi::PERM ? ((R & ~31) + perm32(R & 31)) : R;
        voffA[i] = (unsigned)(R * K + C) * 2u; voffB[i] = (unsigned)(Rb * K + C) * 2u; }
    const size_t kstep = (size_t)(BK * 2);
    const size_t hstep = (size_t)HALF * K * 2;
    const size_t tstep = 2 * hstep;
    const unsigned ldsw = (unsigned)wid * 1024u;
    const int aoff = lds_byte(wr * 64 + fr, fq * 8), boff = lds_byte(wc * 32 + fr, fq * 8);
#define PG8_SA(b, h) (((b) * 2 + (h)) * HTB)
#define PG8_SB(b, h) ((4 + (b) * 2 + (h)) * HTB)
#define PG8_STAGE(bufoff, gbase, voff) do { _Pragma("unroll") for (int _i = 0; _i < 2; ++_i) \
        __builtin_amdgcn_global_load_lds((const unsigned*)((const char*)(gbase) + (voff)[_i]), (PG8_LAS unsigned*)(lds + (bufoff) + ldsw + _i * 8192), 16, 0, 0); } while (0)
#define PG8_LDA(dst, b, h) do { _Pragma("unroll") for (int m = 0; m < 4; ++m) _Pragma("unroll") for (int k = 0; k < 2; ++k) dst[m][k] = *(const PG8_LAS bf16x8*)(lds + PG8_SA(b, h) + aoff + m * 2048 + k * 1024); } while (0)
#define PG8_LDB(dst, b, h) do { _Pragma("unroll") for (int n = 0; n < 2; ++n) _Pragma("unroll") for (int k = 0; k < 2; ++k) dst[n][k] = *(const PG8_LAS bf16x8*)(lds + PG8_SB(b, h) + boff + n * 2048 + k * 1024); } while (0)
#define PG8_MMA(ai, bj, At, Bt) do { __builtin_amdgcn_s_setprio(1); _Pragma("unroll") for (int m = 0; m < 4; ++m) _Pragma("unroll") for (int n = 0; n < 2; ++n) _Pragma("unroll") for (int k = 0; k < 2; ++k) \
        acc[ai][bj][m][n] = __builtin_amdgcn_mfma_f32_16x16x32_f16(Bt[n][k], At[m][k], acc[ai][bj][m][n], 0, 0, 0); __builtin_amdgcn_s_setprio(0); } while (0)
#define PG8_WAIT_V(n) asm volatile("s_waitcnt vmcnt(" #n ")" ::: "memory")
#define PG8_WAIT_L(n) asm volatile("s_waitcnt lgkmcnt(" #n ")" ::: "memory")
#define PG8_BAR __builtin_amdgcn_s_barrier()
#define PG8_SCHED __builtin_amdgcn_sched_barrier(0)
    Unit cur, nxt; int ui = 0;
    if (!S.next(0, cur)) return;
    f32x4 acc[2][2][4][2];
#pragma unroll
    for (int a = 0; a < 2; ++a)
#pragma unroll
        for (int b = 0; b < 2; ++b)
#pragma unroll
            for (int m = 0; m < 4; ++m)
#pragma unroll
                for (int n = 0; n < 2; ++n) acc[a][b][m][n] = (f32x4){0.f, 0.f, 0.f, 0.f};
    bf16x8 At[4][2], B0[2][2], B1[2][2];
    const char* cA = (const char*)g.A + (size_t)cur.pm * tstep; const char* cB = (const char*)g.Bt + (size_t)cur.pn * tstep;
    S.a_ready(cur);
    if constexpr (SP2) {
        PG8_STAGE(PG8_SB(0, 0), cB, voffB); PG8_STAGE(PG8_SB(0, 1), cB + hstep, voffB); PG8_STAGE(PG8_SA(0, 0), cA, voffA); PG8_STAGE(PG8_SA(0, 1), cA + hstep, voffA);
        if (wr == 1) PG8_BAR;
        PG8_WAIT_V(2); PG8_BAR;
        PG8_STAGE(PG8_SB(1, 0), cB + kstep, voffB); PG8_STAGE(PG8_SA(1, 0), cA + kstep, voffA); PG8_STAGE(PG8_SB(1, 1), cB + hstep + kstep, voffB);
        PG8_WAIT_V(6); PG8_BAR;
    } else {
        PG8_STAGE(PG8_SB(0, 0), cB, voffB); PG8_STAGE(PG8_SA(0, 0), cA, voffA); PG8_STAGE(PG8_SB(0, 1), cB + hstep, voffB); PG8_STAGE(PG8_SA(0, 1), cA + hstep, voffA);
        if (wr == 1) PG8_BAR;
        PG8_WAIT_V(4); PG8_BAR;
        PG8_STAGE(PG8_SB(1, 0), cB + kstep, voffB); PG8_STAGE(PG8_SA(1, 0), cA + kstep, voffA); PG8_STAGE(PG8_SB(1, 1), cB + hstep + kstep, voffB);
        PG8_WAIT_V(6); PG8_BAR;
    }
    for (;;) {
        const bool has_next = S.next(ui + 1, nxt);
        const char* nA = has_next ? (const char*)g.A + (size_t)nxt.pm * tstep : cA; const char* nB = has_next ? (const char*)g.Bt + (size_t)nxt.pn * tstep : cB;
        for (int t = 0; t < nt; t += 2) {
            const bool last = (t == nt - 2);
            const char* a1 = cA + (size_t)(t + 1) * kstep;
            const char* a2 = last ? nA : cA + (size_t)(t + 2) * kstep; const char* b2 = last ? nB : cB + (size_t)(t + 2) * kstep;
            const char* a3 = a2 + kstep; const char* b3 = b2 + kstep;
            if (last && has_next) S.a_ready(nxt);
            if constexpr (SP2) {
            PG8_LDB(B0, 0, 0); PG8_LDB(B1, 0, 1); PG8_SCHED; PG8_LDA(At, 0, 0); PG8_STAGE(PG8_SA(1, 1), a1 + hstep, voffA);
            PG8_WAIT_V(8); PG8_WAIT_L(0); PG8_BAR; PG8_MMA(0, 0, At, B0); PG8_MMA(0, 1, At, B1); PG8_BAR; PG8_SCHED;
            PG8_LDA(At, 0, 1); PG8_STAGE(PG8_SB(0, 0), b2, voffB); PG8_STAGE(PG8_SB(0, 1), b2 + hstep, voffB); PG8_STAGE(PG8_SA(0, 0), a2, voffA);
            PG8_WAIT_V(8); PG8_WAIT_L(0); PG8_BAR; PG8_MMA(1, 0, At, B0); PG8_MMA(1, 1, At, B1); PG8_BAR; PG8_SCHED;
            PG8_LDB(B0, 1, 0); PG8_LDB(B1, 1, 1); PG8_SCHED; PG8_LDA(At, 1, 0); PG8_STAGE(PG8_SA(0, 1), a2 + hstep, voffA);
            PG8_WAIT_V(8); PG8_WAIT_L(0); PG8_BAR; PG8_MMA(0, 0, At, B0); PG8_MMA(0, 1, At, B1); PG8_BAR; PG8_SCHED;
            PG8_LDA(At, 1, 1); PG8_STAGE(PG8_SB(1, 0), b3, voffB); PG8_STAGE(PG8_SB(1, 1), b3 + hstep, voffB); PG8_STAGE(PG8_SA(1, 0), a3, voffA);
            PG8_WAIT_V(8); PG8_WAIT_L(0); PG8_BAR; PG8_MMA(1, 0, At, B0); PG8_MMA(1, 1, At, B1); PG8_BAR; PG8_SCHED;
            } else {
            PG8_LDB(B0, 0, 0); PG8_SCHED; PG8_LDA(At, 0, 0); PG8_STAGE(PG8_SA(1, 1), a1 + hstep, voffA);
            PG8_WAIT_L(8); PG8_BAR; PG8_WAIT_L(0); PG8_MMA(0, 0, At, B0); PG8_BAR; PG8_SCHED;
            PG8_LDB(B1, 0, 1); PG8_STAGE(PG8_SB(0, 0), b2, voffB);
            PG8_BAR; PG8_WAIT_L(0); PG8_MMA(0, 1, At, B1); PG8_BAR;
            PG8_LDA(At, 0, 1); PG8_STAGE(PG8_SA(0, 0), a2, voffA);
            PG8_BAR; PG8_WAIT_L(0); PG8_MMA(1, 0, At, B0); PG8_BAR; PG8_SCHED;
            PG8_STAGE(PG8_SB(0, 1), b2 + hstep, voffB);
            PG8_WAIT_V(6); PG8_BAR; PG8_MMA(1, 1, At, B1); PG8_BAR;
            PG8_LDB(B0, 1, 0); PG8_SCHED; PG8_LDA(At, 1, 0); PG8_STAGE(PG8_SA(0, 1), a2 + hstep, voffA);
            PG8_WAIT_L(8); PG8_BAR; PG8_WAIT_L(0); PG8_MMA(0, 0, At, B0); PG8_BAR; PG8_SCHED;
            PG8_LDB(B1, 1, 1); PG8_STAGE(PG8_SB(1, 0), b3, voffB);
            PG8_BAR; PG8_WAIT_L(0); PG8_MMA(0, 1, At, B1); PG8_BAR;
            PG8_LDA(At, 1, 1); PG8_STAGE(PG8_SA(1, 0), a3, voffA);
            PG8_BAR; PG8_WAIT_L(0); PG8_MMA(1, 0, At, B0); PG8_BAR; PG8_SCHED;
            PG8_STAGE(PG8_SB(1, 1), b3 + hstep, voffB);
            PG8_WAIT_V(6); PG8_BAR; PG8_MMA(1, 1, At, B1); PG8_BAR;
            }
        }
        if constexpr (ALIGN_EPI) { if (wr == 0) PG8_BAR; }
        if constexpr (!Epi::AFTER_DRAIN) { E(acc, cur, wr, wc, fr, fq); S.done(cur); }
        if (!has_next) break;
#pragma unroll
        for (int a = 0; a < 2; ++a)
#pragma unroll
            for (int b = 0; b < 2; ++b)
#pragma unroll
                for (int m = 0; m < 4; ++m)
#pragma unroll
                    for (int n = 0; n < 2; ++n) acc[a][b][m][n] = (f32x4){0.f, 0.f, 0.f, 0.f};
        cur = nxt; cA = nA; cB = nB; ++ui;
        if constexpr (ALIGN_EPI) { if (wr == 1) PG8_BAR; }
    }
    PG8_WAIT_V(0);
    if constexpr (!ALIGN_EPI) { if (wr == 0) PG8_BAR; }
    PG8_BAR;
    if constexpr (Epi::AFTER_DRAIN) { E.fused(acc, cur, wr, wc, fr, fq, lds, wid, lane); S.done(cur); }
#undef PG8_SA
#undef PG8_SB
#undef PG8_STAGE
#undef PG8_LDA
#undef PG8_LDB
#undef PG8_MMA
#undef PG8_WAIT_V
#undef PG8_WAIT_L
#undef PG8_BAR
#undef PG8_SCHED
}
}
#include <cmath>
namespace attn_body {
using bf16=_Float16;
using bf16x8=__attribute__((ext_vector_type(8)))short;
using s16x4=__attribute__((ext_vector_type(4)))short;
using f32x16=__attribute__((ext_vector_type(16)))float;
using u32x4=__attribute__((ext_vector_type(4)))unsigned;
constexpr int D=64,QP=512,KP=128;
constexpr int NW=8,QBLK=32,QB=QBLK*NW,KVBLK=64;
constexpr int ATTN_UNIT_ROWS=QB;
__device__ __forceinline__ int crow(int r,int hi){return (r&3)+8*(r>>2)+4*hi;}
#define SBAR() __builtin_amdgcn_sched_barrier(0)
__device__ __forceinline__ void cmask(f32x16&p0,f32x16&p1,int jb,int qrel,int hi){
  const float NEG=-INFINITY; int kb=64*jb+4*hi;
  #pragma unroll
  for(int r=0;r<16;++r){int kv=kb+(r&3)+8*(r>>2); if(kv>qrel)p0[r]=NEG; if(kv+32>qrel)p1[r]=NEG;}
}

constexpr int NSLOT=3, SLOTB=8192;
constexpr int LDS_K=0, LDS_V=NSLOT*SLOTB, LDS_WS=2*NSLOT*SLOTB, LDS_OST=LDS_WS+NW*64*4, LDS_BYTES=LDS_OST+NW*4096;
constexpr float C2=0.125f*1.4426950408889634f;
__device__ __forceinline__ void glds16(const void*gsrc,unsigned lds_dst){unsigned keep;
  asm volatile("s_mov_b32 %0, m0\n\ts_mov_b32 m0, %2\n\ts_nop 0\n\tglobal_load_lds_dwordx4 %1, off\n\ts_mov_b32 m0, %0":"=&s"(keep):"v"(gsrc),"s"(lds_dst):"memory");}
__device__ __forceinline__ float max3f(float a,float b,float c){float r;asm("v_max3_f32 %0, %1, %2, %3":"=v"(r):"v"(a),"v"(b),"v"(c));return r;}
__device__ __forceinline__ float max2f(float a,float b){float r;asm("v_max_f32_e32 %0, %1, %2":"=v"(r):"v"(a),"v"(b));return r;}
__device__ __forceinline__ float fadd_s(float a,float b){float r;asm("v_add_f32_e32 %0, %1, %2":"=v"(r):"v"(a),"v"(b));return r;}
__device__ __forceinline__ float fsub_s(float a,float b){float r;asm("v_sub_f32_e32 %0, %1, %2":"=v"(r):"v"(a),"v"(b));return r;}
typedef _Float16 h16x8_t __attribute__((ext_vector_type(8)));
__device__ __forceinline__ f32x16 mfma32h(bf16x8 a,bf16x8 b,f32x16 c,int,int,int){return __builtin_amdgcn_mfma_f32_32x32x16_f16(__builtin_bit_cast(h16x8_t,a),__builtin_bit_cast(h16x8_t,b),c,0,0,0);}
__device__ __forceinline__ unsigned cvtpk_s(float lo,float hi){return __builtin_bit_cast(unsigned,__builtin_amdgcn_cvt_pkrtz(lo,hi));}
#define WAIT_BAR(N) asm volatile("s_waitcnt vmcnt(" #N ") lgkmcnt(0)\n\ts_barrier":::"memory")

__device__ __forceinline__ void qkt(f32x16&p0,f32x16&p1,const char*Kslot,const bf16x8*qr,const f32x16&negm,int r32,int hi){
  const char*kb=Kslot+hi*1024+r32*16;
  #pragma unroll
  for(int d0=0;d0<4;++d0){
    const bf16x8 b0=*reinterpret_cast<const bf16x8*>(kb+d0*2048);
    const bf16x8 b1=*reinterpret_cast<const bf16x8*>(kb+d0*2048+512);
    if(d0==0){p0=mfma32h(b0,qr[0],negm,0,0,0);p1=mfma32h(b1,qr[0],negm,0,0,0);}
    else{p0=mfma32h(b0,qr[d0],p0,0,0,0);p1=mfma32h(b1,qr[d0],p1,0,0,0);}}
}
typedef __attribute__((address_space(3))) const char* lds_cptr;
typedef short v4i16_t __attribute__((ext_vector_type(4)));
__device__ __forceinline__ void kload8(bf16x8*kf,lds_cptr kp){
  kf[0]=*(const __attribute__((address_space(3))) bf16x8*)(kp);      kf[1]=*(const __attribute__((address_space(3))) bf16x8*)(kp+512);
  kf[2]=*(const __attribute__((address_space(3))) bf16x8*)(kp+2048); kf[3]=*(const __attribute__((address_space(3))) bf16x8*)(kp+2560);
  kf[4]=*(const __attribute__((address_space(3))) bf16x8*)(kp+4096); kf[5]=*(const __attribute__((address_space(3))) bf16x8*)(kp+4608);
  kf[6]=*(const __attribute__((address_space(3))) bf16x8*)(kp+6144); kf[7]=*(const __attribute__((address_space(3))) bf16x8*)(kp+6656);
}
__device__ __forceinline__ void kload2(bf16x8*kf,lds_cptr kp,int j){ kf[2*j]=*(const __attribute__((address_space(3))) bf16x8*)(kp+j*2048); kf[2*j+1]=*(const __attribute__((address_space(3))) bf16x8*)(kp+j*2048+512); }
__device__ __forceinline__ s16x4 vtr(lds_cptr p){ return __builtin_bit_cast(s16x4,__builtin_amdgcn_ds_read_tr16_b64_v4i16((__attribute__((address_space(3))) v4i16_t*)p)); }
__device__ __forceinline__ float rowmax(const f32x16&p0,const f32x16&p1){
  float a=max3f(p0[0],p0[1],p1[0]),b=max3f(p0[2],p0[3],p1[1]);a=max3f(a,p1[2],p1[3]);
  #pragma unroll
  for(int r=4;r<16;r+=4){a=max3f(a,p0[r],p0[r+1]);b=max3f(b,p0[r+2],p0[r+3]);a=max3f(a,p1[r],p1[r+1]);b=max3f(b,p1[r+2],p1[r+3]);}
  const float m=max2f(a,b);
  auto rr=__builtin_amdgcn_permlane32_swap(__float_as_uint(m),__float_as_uint(m),false,false);
  return max2f(__uint_as_float(rr[0]),__uint_as_float(rr[1]));
}
__device__ __forceinline__ void pv(f32x16*o,int vb,bf16x8 pa0,bf16x8 pa1,bf16x8 pa2,bf16x8 pa3){
  #pragma unroll
  for(int d0=0;d0<2;++d0){s16x4 lo[4],hi[4];
    #pragma unroll
    for(int ks=0;ks<4;++ks){
      asm volatile("ds_read_b64_tr_b16 %0,%1 offset:%c2":"=&v"(lo[ks]):"v"(vb),"i"(d0*4096+ks*1024):"memory");
      asm volatile("ds_read_b64_tr_b16 %0,%1 offset:%c2":"=&v"(hi[ks]):"v"(vb),"i"(d0*4096+ks*1024+512):"memory");}
    asm volatile("s_waitcnt lgkmcnt(0)":::"memory");SBAR();
    #define PK(k) (bf16x8){lo[k][0],lo[k][1],lo[k][2],lo[k][3],hi[k][0],hi[k][1],hi[k][2],hi[k][3]}
    o[d0]=mfma32h(pa0,PK(0),o[d0],0,0,0);
    o[d0]=mfma32h(pa1,PK(1),o[d0],0,0,0);
    o[d0]=mfma32h(pa2,PK(2),o[d0],0,0,0);
    o[d0]=mfma32h(pa3,PK(3),o[d0],0,0,0);
    #undef PK
  }
}

#ifndef ATTN_STORE16
#define ATTN_STORE16(p,v) (*(u32x4*)(p)=(v))
#endif
template<int THRL> __device__ __forceinline__ void attn_unit(int h,int qb,int NT,const bf16*Q,const bf16*__restrict__ K,const bf16*__restrict__ V,bf16*O,char*shm){
  const int tid=fresh_tid(),lane=tid&63,r32=lane&31,hi=lane>>5; const int wid=__builtin_amdgcn_readfirstlane(tid>>6);
  const int q0=qb*QB;
  const bf16*Qw=Q+(long)(q0+wid*QBLK)*QP+h*D;
  const bf16*Kh=K+(h>>2)*D,*Vh=V+(h>>2)*D;
  const unsigned lds0=(unsigned)(uintptr_t)shm;
  float*wsf=(float*)(shm+LDS_WS)+wid*64;
  const bf16*ksrc=Kh+(long)lane*KP+wid*8;
  const bf16*vsrc=Vh+(long)(16*(wid&3)+(lane>>2))*KP+(wid>>2)*32+(lane&3)*8;
  const unsigned kdst=lds0+LDS_K+wid*1024, vdst=lds0+LDS_V+wid*1024;
  #define DMA_K(t,slot) glds16(ksrc+(long)(t)*KVBLK*KP,(unsigned)__builtin_amdgcn_readfirstlane(kdst+(slot)))
  #define DMA_V(t,slot) glds16(vsrc+(long)(t)*KVBLK*KP,(unsigned)__builtin_amdgcn_readfirstlane(vdst+(slot)))
  const int vb0=(int)(lds0+LDS_V)+((lane>>4)&1)*32+(lane&3)*8+(4*hi+((lane&15)>>2))*64;
  const char*Kbase=shm+LDS_K; bf16x8 kf[8];
  const lds_cptr shm3=(lds_cptr)shm; const lds_cptr kp0=shm3+LDS_K+hi*1024+r32*16; const lds_cptr vp0=shm3+LDS_V+((lane>>4)&1)*32+(lane&3)*8+(4*hi+((lane&15)>>2))*64;
  DMA_K(0,0);DMA_V(0,0);DMA_K(1,SLOTB);
  bf16x8 qr[4];
  #pragma unroll
  for(int d0=0;d0<4;++d0)qr[d0]=*reinterpret_cast<const bf16x8*>(&Qw[(long)r32*QP+d0*16+hi*8]);
  float mhat=0.f,l_reg=0.f;f32x16 o[2];o[0]=f32x16{};o[1]=f32x16{};f32x16 negm=f32x16{};asm volatile("":"+v"(negm));
  const int qrel=wid*QBLK+r32;
  #define CMASK(P0,P1,t) do{}while(0)
  bool resc=false;
  #define START(P0,P1) do{ const float rm=rowmax(P0,P1); resc=false; \
    { const float dl=rm; mhat=fadd_s(mhat,dl); \
      _Pragma("unroll") for(int r=0;r<16;++r){P0[r]=fsub_s(P0[r],dl);P1[r]=fsub_s(P1[r],dl);} \
      _Pragma("unroll") for(int r=0;r<16;++r)negm[r]=-mhat; asm volatile("":"+v"(negm)); } \
    _Pragma("unroll") for(int r=0;r<16;++r)P0[r]=__builtin_amdgcn_exp2f(P0[r]); }while(0)
  #define RESC() do{ if(resc){ asm volatile("s_waitcnt lgkmcnt(0)":::"memory"); \
      _Pragma("unroll") for(int d_=0;d_<2;++d_) _Pragma("unroll") for(int r=0;r<16;++r)o[d_][r]*=wsf[crow(r,hi)]; } }while(0)
  f32x16 pA0,pA1,pB0,pB1;
  int sl_prev=0,sl_cur=0,sl_next=SLOTB;
  #define ROT() do{sl_prev=sl_cur;sl_cur=sl_next;sl_next=(sl_next==(NSLOT-1)*SLOTB)?0:sl_next+SLOTB;}while(0)
  DMA_K(2,2*SLOTB);
  WAIT_BAR(3);
  qkt(pA0,pA1,Kbase,qr,negm,r32,hi);asm volatile("s_nop 15\n\ts_nop 7":"+v"(pA0),"+v"(pA1));CMASK(pA0,pA1,0);
  START(pA0,pA1);
  _Pragma("unroll") for(int r=0;r<16;++r)pA1[r]=__builtin_amdgcn_exp2f(pA1[r]);
  WAIT_BAR(0);
  DMA_K(3,0);DMA_V(1,SLOTB);
  ROT();
  kload8(kf,kp0+sl_cur);
  WAIT_BAR(2);
  s16x4 vlo[8],vhi[8]; u32x4 pw0,pw1,pw2,pw3;
  #define PKW(P,B) cvtpk_s(P[B],P[B+1])
  #define PAF(k) __builtin_bit_cast(bf16x8,pw##k)
  #define VFR(i) (bf16x8){vlo[i][0],vlo[i][1],vlo[i][2],vlo[i][3],vhi[i][0],vhi[i][1],vhi[i][2],vhi[i][3]}
  #define PIN(x) asm volatile("":"+v"(x))
  #define MX3(a,b,c) __builtin_fmaxf(__builtin_fmaxf((a),(b)),(c))
  #define GAPA(MF,A0,A1,A2,A3,W0,W1,PW) do{ MF; sacc+=A0; sacc+=A1; sacc+=A2; sacc+=A3; PIN(sacc); W0; W1; PIN(PW); SBAR(); }while(0)
  #define EX(v) __builtin_amdgcn_exp2f(v)
  #define GAPB(MF,X,B) do{ MF; X[B]=EX(X[B]); X[B+1]=EX(X[B+1]); X[B+2]=EX(X[B+2]); X[B+3]=EX(X[B+3]); PIN(X); SBAR(); }while(0)
  #define VRD(i) do{ vlo[i]=vtr(vp_+(((i)>>2)*4096+((i)&3)*1024)); vhi[i]=vtr(vp_+(((i)>>2)*4096+((i)&3)*1024+512)); }while(0)
  #define KRD(G,j) do{ if(G){ kload2(kf,kp0+sl_next,j); SBAR(); } }while(0)
  #define STEP(C0,C1,P0,P1,t,GK,GV,GL) do{ SBAR(); \
    const lds_cptr vp_=vp0+sl_prev; \
    VRD(0); SBAR(); float sacc=(P0[0]+P0[1]); \
    GAPA(C0=mfma32h(kf[0],qr[0],negm,0,0,0), P0[2],P0[3],P0[4],P0[5],     pw0[0]=PKW(P0,0), pw0[1]=PKW(P0,2), pw0); \
    VRD(4); SBAR(); GAPA(C1=mfma32h(kf[1],qr[0],negm,0,0,0), P0[6],P0[7],P0[8],P0[9],     pw0[2]=PKW(P0,4), pw0[3]=PKW(P0,6), pw0); \
    VRD(1); SBAR(); GAPA(C0=mfma32h(kf[2],qr[1],C0,0,0,0),   P0[10],P0[11],P0[12],P0[13], pw1[0]=PKW(P0,8), pw1[1]=PKW(P0,10), pw1); \
    VRD(5); SBAR(); GAPA(C1=mfma32h(kf[3],qr[1],C1,0,0,0),   P0[14],P0[15],P1[0],P1[1],   pw1[2]=PKW(P0,12),pw1[3]=PKW(P0,14), pw1); \
    VRD(2); SBAR(); GAPA(C0=mfma32h(kf[4],qr[2],C0,0,0,0),   P1[2],P1[3],P1[4],P1[5],     pw2[0]=PKW(P1,0), pw2[1]=PKW(P1,2), pw2); \
    VRD(6); SBAR(); GAPA(C1=mfma32h(kf[5],qr[2],C1,0,0,0),   P1[6],P1[7],P1[8],P1[9],     pw2[2]=PKW(P1,4), pw2[3]=PKW(P1,6), pw2); \
    VRD(3); SBAR(); GAPA(C0=mfma32h(kf[6],qr[3],C0,0,0,0),   P1[10],P1[11],P1[12],P1[13], pw3[0]=PKW(P1,8), pw3[1]=PKW(P1,10), pw3); \
    VRD(7); SBAR(); GAPA(C1=mfma32h(kf[7],qr[3],C1,0,0,0),   P1[14],P1[15],0.f,0.f,       pw3[2]=PKW(P1,12),pw3[3]=PKW(P1,14), pw3); \
    l_reg+=sacc; \
    if(GK){DMA_K((t)+3,sl_cur);} if(GV){DMA_V((t)+1,sl_next);} \
    CMASK(C0,C1,t); \
    { float a=MX3(C0[0],C0[1],C1[0]),b=MX3(C0[2],C0[3],C1[1]); a=MX3(a,C1[2],C1[3]); \
      _Pragma("unroll") for(int r=4;r<16;r+=4){a=MX3(a,C0[r],C0[r+1]);b=MX3(b,C0[r+2],C0[r+3]);a=MX3(a,C1[r],C1[r+1]);b=MX3(b,C1[r+2],C1[r+3]);} \
      float rm=__builtin_fmaxf(a,b); { auto rr=__builtin_amdgcn_permlane32_swap(__float_as_uint(rm),__float_as_uint(rm),false,false); rm=__builtin_fmaxf(__uint_as_float(rr[0]),__uint_as_float(rr[1])); } \
      resc=false; \
      if(__builtin_expect(__any(rm>(float)THRL),0)){ const float dl=__builtin_fmaxf(rm,0.f); mhat+=dl; \
        _Pragma("unroll") for(int r=0;r<16;++r){C0[r]-=dl;C1[r]-=dl;} \
        _Pragma("unroll") for(int r=0;r<16;++r)negm[r]=-mhat; asm volatile("":"+v"(negm)); \
        const float f=__builtin_amdgcn_exp2f(-dl); l_reg*=f; if(hi==0)wsf[r32]=f; resc=true; } } \
    SBAR(); \
    GAPB(o[0]=mfma32h(PAF(0),VFR(0),o[0],0,0,0), C0,0); \
    GAPB(o[1]=mfma32h(PAF(0),VFR(4),o[1],0,0,0), C0,4); \
    KRD(GL,0); GAPB(o[0]=mfma32h(PAF(1),VFR(1),o[0],0,0,0), C0,8); \
    KRD(GL,1); GAPB(o[1]=mfma32h(PAF(1),VFR(5),o[1],0,0,0), C0,12); \
    KRD(GL,2); GAPB(o[0]=mfma32h(PAF(2),VFR(2),o[0],0,0,0), C1,0); \
    KRD(GL,3); GAPB(o[1]=mfma32h(PAF(2),VFR(6),o[1],0,0,0), C1,4); \
    GAPB(o[0]=mfma32h(PAF(3),VFR(3),o[0],0,0,0), C1,8); \
    GAPB(o[1]=mfma32h(PAF(3),VFR(7),o[1],0,0,0), C1,12); \
    }while(0)
  int t=1;
  #undef CMASK
  #define CMASK(P0,P1,t) do{}while(0)
  for(;t+5<NT;t+=2){
    STEP(pB0,pB1,pA0,pA1,t,true,true,true);     WAIT_BAR(2); RESC(); ROT();
    STEP(pA0,pA1,pB0,pB1,t+1,true,true,true);   WAIT_BAR(2); RESC(); ROT();
  }
  #undef CMASK
  #define CMASK(P0,P1,t) do{}while(0)
  #define ENDW(tt) do{ if((tt)+3<NT){WAIT_BAR(2);} else if((tt)+2<NT){WAIT_BAR(1);} else {WAIT_BAR(0);} }while(0)
  for(;t+1<NT;t+=2){
    STEP(pB0,pB1,pA0,pA1,t,(t+3<NT),(t+1<NT),(t+1<NT));       ENDW(t);   RESC(); ROT();
    STEP(pA0,pA1,pB0,pB1,t+1,(t+4<NT),(t+2<NT),(t+2<NT));     ENDW(t+1); RESC(); ROT();
  }
  STEP(pB0,pB1,pA0,pA1,NT-1,false,false,false); RESC();
  { float sacc=pB0[0]+pB0[1]; _Pragma("unroll") for(int r=2;r<16;++r)sacc+=pB0[r]; _Pragma("unroll") for(int r=0;r<16;++r)sacc+=pB1[r]; l_reg+=sacc;
    pw0=(u32x4){PKW(pB0,0),PKW(pB0,2),PKW(pB0,4),PKW(pB0,6)};pw1=(u32x4){PKW(pB0,8),PKW(pB0,10),PKW(pB0,12),PKW(pB0,14)};pw2=(u32x4){PKW(pB1,0),PKW(pB1,2),PKW(pB1,4),PKW(pB1,6)};pw3=(u32x4){PKW(pB1,8),PKW(pB1,10),PKW(pB1,12),PKW(pB1,14)};
    SBAR(); pv(o,vb0+sl_cur,PAF(0),PAF(1),PAF(2),PAF(3)); }
  #undef PKW
  #undef PAF
  #undef VFR
  #undef PIN
  #undef MX3
  #undef GAPA
  #undef GAPB
  #undef EX
  #undef VRD
  #undef KRD
  #undef STEP
  #undef ENDW
  {auto rr=__builtin_amdgcn_permlane32_swap(__float_as_uint(l_reg),__float_as_uint(l_reg),false,false);l_reg=__uint_as_float(rr[0])+__uint_as_float(rr[1]);}
  if(hi==0)wsf[32+r32]=l_reg;asm volatile("s_waitcnt lgkmcnt(0)":::"memory");
  float rli[16];
  #pragma unroll
  for(int r=0;r<16;++r)rli[r]=__builtin_amdgcn_rcpf(wsf[32+crow(r,hi)]);
  bf16*Ow=O+(long)(q0+wid*QBLK)*QP+h*D;
  { bf16*stg=(bf16*)(shm+LDS_OST)+wid*2048;
    #pragma unroll
    for(int r=0;r<16;++r){const int orow=crow(r,hi);
      #pragma unroll
      for(int d0=0;d0<2;++d0)stg[orow*64+d0*32+r32]=(_Float16)(o[d0][r]*rli[r]);}
    asm volatile("s_waitcnt lgkmcnt(0)":::"memory");
    #pragma unroll
    for(int i=0;i<4;++i){const int row=i*8+(lane>>3),ch=lane&7; const u32x4 v=*(const u32x4*)(stg+row*64+ch*8); ATTN_STORE16(Ow+(long)row*QP+ch*8,v);} }
  asm volatile("s_waitcnt lgkmcnt(0)\n\ts_barrier":::"memory");
  #undef DMA_K
  #undef DMA_V
  #undef CMASK
  #undef START
  #undef RESC
  #undef ROT
}
constexpr int ATTN_LDS_BYTES=LDS_BYTES;
#undef SBAR
#undef WAIT_BAR
}
#ifndef LAS
#define LAS __attribute__((address_space(3)))
#endif
#define XB_TMO      128
#define XB_XCNT(j)  (256  + 64 * (j))
#define XB_XSUB(j)  (1280 + 64 * (j))
#define XB_XGEN(j)  (2304 + 64 * (j))
#define XB_TOP      3328
#define XB_TOPGEN   3392
#define XCD_BAR_WORDS 3456
#define XB_SPIN_CAP (1u << 18)

__device__ __forceinline__ unsigned xb_ld(unsigned* p)              { return __hip_atomic_load(p, __ATOMIC_RELAXED, __HIP_MEMORY_SCOPE_AGENT); }
__device__ __forceinline__ unsigned xb_add(unsigned* p, unsigned v) { return __hip_atomic_fetch_add(p, v, __ATOMIC_RELAXED, __HIP_MEMORY_SCOPE_AGENT); }
__device__ __forceinline__ unsigned xb_xcc_id() { return (unsigned)__builtin_amdgcn_s_getreg((3 << 11) | 20) & 0xFu; }
#define XB_SPIN(cond, bar) do { unsigned _sp = 0; while (cond) { __builtin_amdgcn_s_sleep(1); \
    if ((++_sp & 255u) == 0u) { if (xb_ld(&(bar)[XB_TMO])) break; if (_sp > XB_SPIN_CAP) { atomicAdd(&(bar)[XB_TMO], 1u); break; } } } } while (0)

struct XcdBarrier {
    unsigned* bar; unsigned x;
    volatile LAS unsigned* st;
};

__device__ __forceinline__ XcdBarrier xcd_barrier_post(unsigned* bar, volatile LAS unsigned* st) {
    XcdBarrier b; b.bar = bar; b.x = xb_xcc_id(); b.st = st;
    if (threadIdx.x == 0) (void)xb_add(&bar[XB_XCNT(b.x)], 1u);
    return b;
}
__device__ __forceinline__ void xcd_barrier_complete(unsigned* bar, unsigned x, unsigned& nloc, unsigned& nx) {
    const unsigned G = gridDim.x * gridDim.y * gridDim.z;
    unsigned sum, cnt, mine, sp = 0u;
    for (;;) {
        sum = 0u; cnt = 0u; mine = 0u;
#pragma unroll
        for (unsigned j = 0; j < 16; ++j) { const unsigned c = xb_ld(&bar[XB_XCNT(j)]); sum += c; cnt += (c > 0u) ? 1u : 0u; mine = (j == x) ? c : mine; }
        if (sum == G) break;
        __builtin_amdgcn_s_sleep(1);
        if ((++sp & 255u) == 0u) { if (xb_ld(&bar[XB_TMO])) break; if (sp > XB_SPIN_CAP) { atomicAdd(&bar[XB_TMO], 1u); break; } }
    }
    nloc = mine > 0u ? mine : 1u; nx = cnt > 0u ? cnt : 1u;
}

__device__ __forceinline__ void xcd_barrier(const XcdBarrier& b) {
    asm volatile("s_waitcnt vmcnt(0)" ::: "memory");
    __syncthreads();
    if (threadIdx.x == 0) {
        unsigned* bar = b.bar;
        __builtin_amdgcn_s_waitcnt(0);
        unsigned nloc = b.st[0], nx = b.st[1];
        if (nloc == 0u) { xcd_barrier_complete(bar, b.x, nloc, nx); b.st[0] = nloc; b.st[1] = nx; }
        const unsigned old = xb_add(&bar[XB_XSUB(b.x)], 1u);
        const unsigned gen = old / nloc;
        if (old + 1u == (gen + 1u) * nloc) {
            __builtin_amdgcn_fence(__ATOMIC_RELEASE, "agent");
            asm volatile("s_waitcnt vmcnt(0)" ::: "memory");
            const unsigned og = xb_add(&bar[XB_TOP], 1u);
            const unsigned tg = og / nx;
            if (og + 1u == (tg + 1u) * nx) xb_add(&bar[XB_TOPGEN], 1u);
            else XB_SPIN(xb_ld(&bar[XB_TOPGEN]) == tg, bar);
            __builtin_amdgcn_fence(__ATOMIC_ACQUIRE, "agent");
            xb_add(&bar[XB_XGEN(b.x)], 1u);
            asm volatile("s_waitcnt vmcnt(0)" ::: "memory");
        } else {
            XB_SPIN(xb_ld(&bar[XB_XGEN(b.x)]) == gen, bar);
            __builtin_amdgcn_fence(__ATOMIC_ACQUIRE, "agent");
            asm volatile("s_waitcnt vmcnt(0)" ::: "memory");
        }
    }
    __syncthreads();
}
typedef _Float16 f16;
typedef _Float16 h16x8 __attribute__((ext_vector_type(8)));
typedef _Float16 h16x4 __attribute__((ext_vector_type(4)));
typedef float f32x4 __attribute__((ext_vector_type(4)));
typedef unsigned u32x4 __attribute__((ext_vector_type(4)));
typedef unsigned u32x2 __attribute__((ext_vector_type(2)));
using pg8::pk2h; using pg8::silu_f; using pg8::sigm_f;

constexpr int NWAVES = 8, NTHR = 512;
constexpr int DMODEL = 1024, SEQ = 16384, CTX = 256, T = SEQ + CTX, DEPTH = 4, DFF = 2816, INW = 6400, NMOD = 9;
constexpr int C_Q = 0, C_K = 512, C_V = 640, C_F = 768, C_CG = 1024, C_SC = 1536, C_G = 2304;
constexpr float EPS = 1e-6f;
constexpr float QSCALE = 0.125f * 1.4426950408889634f;
enum { I_X = 0, I_C, I_CTX, I_CCTX, I_WADA, I_BADA, I_NORMG, I_W13, I_W2, I_WIN, I_BGATE, I_QNG, I_KNG, I_WAO, I_WFN, I_CDW, I_CDB, I_CLG, I_CLB, I_WCO, I_SCW, I_WSO, I_WO, I_FNG, N_IN };

constexpr size_t MiB = 1u << 20;
constexpr size_t WS_MOD = 1 * MiB;
constexpr size_t WS_D1 = 2 * MiB;
constexpr size_t WS_D2 = WS_D1 + 65536;
constexpr size_t WS_DC = WS_D2 + 131072;
constexpr size_t WS_W = 4 * MiB;
constexpr size_t W13_E = (size_t)2 * DFF * DMODEL;
constexpr size_t W2_E = (size_t)DMODEL * DFF;
constexpr size_t OFF_W13 = 0, OFF_W2 = OFF_W13 + 2 * W13_E, OFF_WIN = OFF_W2 + 2 * W2_E, OFF_WA = OFF_WIN + (size_t)INW * DMODEL,
                 OFF_WF = OFF_WA + 1024 * 512, OFF_WC = OFF_WF + 1024 * 512, OFF_WS = OFF_WC + 1024 * 256, OFF_WO = OFF_WS + 1024 * 256, W_TOTAL_E = OFF_WO + 1024 * 1024;
constexpr size_t WS_X = 56 * MiB;
constexpr size_t WS_H = 122 * MiB;
constexpr size_t WS_MH = 155 * MiB;
constexpr size_t WS_WINB = 188 * MiB;
constexpr size_t WS_M32 = 392 * MiB;
constexpr size_t WS_QB = 458 * MiB;
constexpr size_t WS_AO = 475 * MiB;
constexpr size_t WS_FO = 492 * MiB;
constexpr size_t WS_KB = 509 * MiB;
constexpr size_t WS_VB = 514 * MiB;
constexpr size_t WS_CV = 519 * MiB;
constexpr size_t WS_SCB = 528 * MiB;
constexpr size_t WS_AP = 537 * MiB;
constexpr size_t WS_END = 554 * MiB;
static_assert(WS_W + W_TOTAL_E * 2 <= WS_X && WS_X + (size_t)T * 1024 * 4 <= WS_H && WS_H + (size_t)T * 2048 <= WS_MH && WS_MH + (size_t)T * 2048 <= WS_WINB &&
              WS_WINB + (size_t)T * INW * 2 <= WS_M32 && WS_M32 + (size_t)T * 4096 <= WS_QB && WS_QB + (size_t)T * 1024 <= WS_AO && WS_AO + (size_t)T * 1024 <= WS_FO &&
              WS_FO + (size_t)T * 1024 <= WS_KB && WS_KB + (size_t)T * 256 <= WS_VB && WS_VB + (size_t)T * 256 <= WS_CV && WS_CV + (size_t)T * 512 <= WS_SCB &&
              WS_SCB + (size_t)T * 512 <= WS_AP && WS_AP + 16 * MiB <= WS_END, "d_ws map");
constexpr int LDS_BYTES = 147456;
constexpr int LDS_TAB = 143360;
constexpr int LDS_BARST = 143360 + 1024;
constexpr size_t WS_BAR = 0;

struct Args { const float* in[N_IN]; float* out; unsigned char* ws; };

__device__ __forceinline__ void sincos_turns(float t, float* sn, float* cs) { *sn = __builtin_amdgcn_sinf(t); *cs = __builtin_amdgcn_cosf(t); }
__device__ __forceinline__ float wave_sum(float v) {
#pragma unroll
    for (int o = 1; o < 64; o <<= 1) v += __shfl_xor(v, o);
    return v;
}

__device__ __forceinline__ void transpose_item(const float* W, int K, int N, f16* WT, bool swz, LAS float* scr, int item, int lane) {
    const int nblk = N / 32, kb = item / nblk, nb = item % nblk, k0 = 64 * kb, n0 = 32 * nb;
#pragma unroll 8
    for (int i = 0; i < 32; ++i) { const int kk = 2 * i + (lane >> 5); scr[kk * 33 + (lane & 31)] = W[(size_t)(k0 + kk) * N + n0 + (lane & 31)]; }
    asm volatile("s_waitcnt lgkmcnt(0)" ::: "memory");
    int r0 = n0;
    if (swz) { const int blk = n0 >> 7, within = n0 & 127; r0 = (blk < 22) ? (256 * blk + within) : (256 * (blk - 22) + 128 + within); }
    const int c = lane & 7;
#pragma unroll
    for (int j = 0; j < 4; ++j) { const int n = (lane >> 3) + 8 * j; const LAS float* s = scr + (8 * c) * 33 + n;
        u32x4 o; o.x = pk2h(s[0 * 33], s[1 * 33]); o.y = pk2h(s[2 * 33], s[3 * 33]); o.z = pk2h(s[4 * 33], s[5 * 33]); o.w = pk2h(s[6 * 33], s[7 * 33]);
        *(u32x4*)(WT + (size_t)(r0 + n) * K + k0 + 8 * c) = o; }
    asm volatile("s_waitcnt lgkmcnt(0)" ::: "memory");
}
__device__ __forceinline__ void convert_weights(const KP& a, int l, LAS unsigned char* lds, int gw, int NGW, int wave, int lane) {
    LAS float* scr = (LAS float*)(lds + wave * 16384);
    f16* WB = (f16*)(a.ws() + WS_W);
    constexpr int IT13 = 16 * 176, IT2 = 44 * 32, ITIN = 16 * 200, ITA = 8 * 32, ITC = 4 * 32, ITO = 16 * 32;
    constexpr int NITEMS = 2 * IT13 + 2 * IT2 + ITIN + ITA + 2 * ITC + ITO;
    for (int it = gw; it < NITEMS; it += NGW) {
        int r = it;
        if (r < 2 * IT13) { const int s = r / IT13; transpose_item(a.in(I_W13) + (size_t)(l * 2 + s) * DMODEL * 2 * DFF, DMODEL, 2 * DFF, WB + OFF_W13 + s * W13_E, true, scr, r % IT13, lane); continue; } r -= 2 * IT13;
        if (r < 2 * IT2) { const int s = r / IT2; transpose_item(a.in(I_W2) + (size_t)(l * 2 + s) * DFF * DMODEL, DFF, DMODEL, WB + OFF_W2 + s * W2_E, false, scr, r % IT2, lane); continue; } r -= 2 * IT2;
        if (r < ITIN) { transpose_item(a.in(I_WIN) + (size_t)l * DMODEL * INW, DMODEL, INW, WB + OFF_WIN, false, scr, r, lane); continue; } r -= ITIN;
        if (r < ITA) { transpose_item(a.in(I_WAO) + (size_t)l * 512 * 1024, 512, 1024, WB + OFF_WA, false, scr, r, lane); continue; } r -= ITA;
        if (r < ITC) { transpose_item(a.in(I_WCO) + (size_t)l * 256 * 1024, 256, 1024, WB + OFF_WC, false, scr, r, lane); continue; } r -= ITC;
        if (r < ITC) { transpose_item(a.in(I_WSO) + (size_t)l * 256 * 1024, 256, 1024, WB + OFF_WS, false, scr, r, lane); continue; } r -= ITC;
        transpose_item(a.in(I_WO) + (size_t)l * 1024 * 1024, 1024, 1024, WB + OFF_WO, false, scr, r, lane);
    }
    const LAS float* ctab = (const LAS float*)(lds + LDS_TAB); const LAS float* stab = ctab + 64;
    const float* wf = a.in(I_WFN) + (size_t)l * 256 * 1024;
    const int gt = blockIdx.x * NTHR + fresh_tid(), GT = gridDim.x * NTHR;
    for (int idx = gt; idx < 65536; idx += GT) {
        const int o = idx & 1023, rest = idx >> 10, j8 = rest & 7, g = (rest >> 3) & 3, part = rest >> 5;
        float acc[8];
#pragma unroll
        for (int i = 0; i < 8; ++i) acc[i] = 0.f;
        const LAS float* tab = part ? stab : ctab;
        for (int m = 0; m < 64; ++m) { const float wv = wf[(size_t)(g * 64 + m) * 1024 + o];
#pragma unroll
            for (int i = 0; i < 8; ++i) acc[i] += tab[(m * (j8 * 8 + i)) & 63] * wv; }
        u32x4 w; w.x = pk2h(acc[0] * 0.125f, acc[1] * 0.125f); w.y = pk2h(acc[2] * 0.125f, acc[3] * 0.125f); w.z = pk2h(acc[4] * 0.125f, acc[5] * 0.125f); w.w = pk2h(acc[6] * 0.125f, acc[7] * 0.125f);
        *(u32x4*)(WB + OFF_WF + (size_t)o * 512 + part * 256 + g * 64 + j8 * 8) = w;
    }
}
__device__ __forceinline__ void phase0(const KP& a, LAS unsigned char* lds, int gw, int NGW, int wave, int lane) {
    const int tid = fresh_tid();
    {
        LAS float* sl = (LAS float*)lds; LAS float* sc = sl + 1024; LAS float* red = sl + 2048;
        float* MOD = (float*)(a.ws() + WS_MOD);
        bool have = false;
        for (int u = blockIdx.x; u < DEPTH * 36; u += gridDim.x) {
            if (!have) { for (int k = tid; k < 1024; k += NTHR) { sl[k] = silu_f(a.in(I_C)[k]); sc[k] = silu_f(a.in(I_CCTX)[k]); } have = true; __syncthreads(); }
            const int l = u / 36, strip = u % 36;
            const float* wp = a.in(I_WADA) + ((size_t)l * 1024 + wave * 128) * 9216 + strip * 256 + 4 * lane;
            f32x4 a0 = {0.f, 0.f, 0.f, 0.f}, a1 = {0.f, 0.f, 0.f, 0.f};
#pragma unroll 8
            for (int k = 0; k < 128; ++k) { const f32x4 wv = *(const f32x4*)(wp + (size_t)k * 9216); a0 += sl[wave * 128 + k] * wv; a1 += sc[wave * 128 + k] * wv; }
            *(LAS f32x4*)(red + (wave * 2 + 0) * 256 + 4 * lane) = a0; *(LAS f32x4*)(red + (wave * 2 + 1) * 256 + 4 * lane) = a1;
            __syncthreads();
            { const int s = tid >> 8, c = tid & 255; float v = a.in(I_BADA)[l * 9216 + strip * 256 + c];
#pragma unroll
              for (int w = 0; w < 8; ++w) v += red[(w * 2 + s) * 256 + c];
              MOD[(size_t)(l * 2 + s) * 9216 + strip * 256 + c] = v; }
            __syncthreads();
        }
        __syncthreads();
    }
    const int gt = blockIdx.x * NTHR + tid, GT = gridDim.x * NTHR;
    { f16* D1 = (f16*)(a.ws() + WS_D1); f16* D2 = (f16*)(a.ws() + WS_D2); f16* DC = (f16*)(a.ws() + WS_DC);
      const float s128 = 0.08838834764831845f;
      for (int i = gt; i < 32768 + 65536 + 131072; i += GT) {
          float sn, cs;
          if (i < 32768) { const int r = i >> 7, n1 = i & 127, k1 = r & 127; sincos_turns((float)((k1 * n1) & 127) * (1.0f / 128.0f), &sn, &cs); D1[i] = (f16)((r < 128 ? cs : -sn) * s128); }
          else if (i < 32768 + 65536) { const int ii = i - 32768, r = ii >> 8, kk = ii & 255, k2 = r & 127, n2 = kk >> 1, p = kk & 1; sincos_turns((float)((k2 * n2) & 127) * (1.0f / 128.0f), &sn, &cs);
              const float v = (r < 128) ? (p ? sn : cs) : (p ? cs : -sn); D2[ii] = (f16)(v * s128); }
          else { const int ii = i - 32768 - 65536, h = ii >> 16, r = (ii >> 8) & 255, n = ii & 255, rt = r >> 7, k = 128 * h + (r & 127); sincos_turns((float)((k * n) & 255) * (1.0f / 256.0f), &sn, &cs);
              DC[ii] = (f16)((rt ? -sn : cs) * 0.0625f); }
      } }
    { const f32x4* s0 = (const f32x4*)a.in(I_CTX); const f32x4* s1 = (const f32x4*)a.in(I_X); f32x4* X = (f32x4*)(a.ws() + WS_X);
      for (int i = gt; i < T * 256; i += GT) X[i] = (i < CTX * 256) ? s0[i] : s1[i - CTX * 256]; }
    convert_weights(a, 0, lds, gw, NGW, wave, lane);
}

__device__ __forceinline__ void norm_phase(const KP& a, int l, int slot, int gw, int NGW, int lane) {
    const float* X = (const float*)(a.ws() + WS_X); f16* H = (f16*)(a.ws() + WS_H);
    const float* g = a.in(I_NORMG) + (size_t)(l * 3 + slot) * 1024; const float* MOD = (const float*)(a.ws() + WS_MOD);
    for (int r = gw; r < T; r += NGW) {
        const float* md = MOD + (size_t)(l * 2 + (r < CTX ? 1 : 0)) * 9216; const float* shift = md + (3 * slot) * 1024; const float* scale = md + (3 * slot + 1) * 1024;
        const f32x4* xr = (const f32x4*)(X + (size_t)r * 1024) + lane;
        f32x4 v[4]; float ss = 0.f;
#pragma unroll
        for (int j = 0; j < 4; ++j) { v[j] = xr[64 * j]; ss += (v[j].x * v[j].x + v[j].y * v[j].y) + (v[j].z * v[j].z + v[j].w * v[j].w); }
        const float rstd = 1.0f / sqrtf(wave_sum(ss) * (1.0f / 1024.0f) + EPS);
        u32x2* o8 = (u32x2*)(H + (size_t)r * 1024) + lane;
#pragma unroll
        for (int j = 0; j < 4; ++j) { const int c = 4 * lane + 256 * j; const f32x4 gg = *(const f32x4*)(g + c), sc = *(const f32x4*)(scale + c), sh = *(const f32x4*)(shift + c);
            const f32x4 o = (v[j] * rstd) * gg * (sc + 1.0f) + sh; u32x2 w; w.x = pk2h(o.x, o.y); w.y = pk2h(o.z, o.w); o8[64 * j] = w; }
    }
}
__device__ __forceinline__ void final_norm(const KP& a, int gw, int NGW, int lane) {
    const float* X = (const float*)(a.ws() + WS_X) + (size_t)CTX * 1024; const float* g = a.in(I_FNG);
    for (int r = gw; r < SEQ; r += NGW) {
        const f32x4* xr = (const f32x4*)(X + (size_t)r * 1024) + lane;
        f32x4 v[4]; float ss = 0.f;
#pragma unroll
        for (int j = 0; j < 4; ++j) { v[j] = xr[64 * j]; ss += (v[j].x * v[j].x + v[j].y * v[j].y) + (v[j].z * v[j].z + v[j].w * v[j].w); }
        const float rstd = 1.0f / sqrtf(wave_sum(ss) * (1.0f / 1024.0f) + EPS);
        f32x4* o = (f32x4*)(a.out() + (size_t)r * 1024) + lane;
#pragma unroll
        for (int j = 0; j < 4; ++j) o[64 * j] = (v[j] * rstd) * *(const f32x4*)(g + 4 * lane + 256 * j);
    }
}

__device__ __forceinline__ void qkv_prep(const KP& a, int l, int gw, int NGW, int lane) {
    const f16* WINB = (const f16*)(a.ws() + WS_WINB); f16* QB = (f16*)(a.ws() + WS_QB); f16* KB = (f16*)(a.ws() + WS_KB); f16* VB = (f16*)(a.ws() + WS_VB);
    const int j = lane & 7;
    float gq[8], gk[8], invf[8];
#pragma unroll
    for (int i = 0; i < 8; ++i) { gq[i] = a.in(I_QNG)[l * 64 + j * 8 + i]; gk[i] = a.in(I_KNG)[l * 64 + j * 8 + i];
        invf[i] = exp2f(-(float)(8 * (j & 1) + i) * (13.287712379549449f / 16.0f)); }
    const bool p1 = (j >> 1) & 1;
    for (int r = gw; r < T; r += NGW) {
        const f16* wrow = WINB + (size_t)r * INW;
        float cs[8], sn[8];
        const bool lat = r >= CTX;
        if (lat) { const int n = r - CTX; const float pos = (float)((j >> 2) ? (n & 63) : (n >> 6));
#pragma unroll
            for (int i = 0; i < 8; ++i) { const float ang = pos * invf[i]; sincos_turns(ang * 0.15915494309189535f, &sn[i], &cs[i]); } }
        else {
#pragma unroll
            for (int i = 0; i < 8; ++i) { cs[i] = 1.f; sn[i] = 0.f; } }
        { const h16x8 qv = *(const h16x8*)(wrow + C_Q + lane * 8); float x[8]; float ss = 0.f;
#pragma unroll
          for (int i = 0; i < 8; ++i) { x[i] = (float)qv[i]; ss += x[i] * x[i]; }
          ss += __shfl_xor(ss, 1); ss += __shfl_xor(ss, 2); ss += __shfl_xor(ss, 4);
          const float rs = 1.0f / sqrtf(ss * (1.0f / 64.0f) + EPS);
          float y[8];
#pragma unroll
          for (int i = 0; i < 8; ++i) { x[i] = x[i] * rs * gq[i]; }
#pragma unroll
          for (int i = 0; i < 8; ++i) { const float xp = __shfl_xor(x[i], 2); y[i] = p1 ? (xp * sn[i] + x[i] * cs[i]) : (x[i] * cs[i] - xp * sn[i]); y[i] *= QSCALE; }
          u32x4 w; w.x = pk2h(y[0], y[1]); w.y = pk2h(y[2], y[3]); w.z = pk2h(y[4], y[5]); w.w = pk2h(y[6], y[7]);
          *(u32x4*)(QB + (size_t)r * 512 + lane * 8) = w; }
        { const int lk = lane & 15; const h16x8 kv = *(const h16x8*)(wrow + C_K + lk * 8); float x[8]; float ss = 0.f;
#pragma unroll
          for (int i = 0; i < 8; ++i) { x[i] = (float)kv[i]; ss += x[i] * x[i]; }
          ss += __shfl_xor(ss, 1); ss += __shfl_xor(ss, 2); ss += __shfl_xor(ss, 4);
          const float rs = 1.0f / sqrtf(ss * (1.0f / 64.0f) + EPS);
          float y[8];
#pragma unroll
          for (int i = 0; i < 8; ++i) { x[i] = x[i] * rs * gk[i]; }
#pragma unroll
          for (int i = 0; i < 8; ++i) { const float xp = __shfl_xor(x[i], 2); y[i] = p1 ? (xp * sn[i] + x[i] * cs[i]) : (x[i] * cs[i] - xp * sn[i]); }
          u32x4 w; w.x = pk2h(y[0], y[1]); w.y = pk2h(y[2], y[3]); w.z = pk2h(y[4], y[5]); w.w = pk2h(y[6], y[7]);
          if (lane < 16) *(u32x4*)(KB + (size_t)r * 128 + lane * 8) = w;
          else if (lane < 32) *(u32x4*)(VB + (size_t)r * 128 + (lane - 16) * 8) = *(const u32x4*)(wrow + C_V + (lane - 16) * 8); }
    }
}
__device__ __forceinline__ void conv_unit(const KP& a, int l, int u, LAS unsigned char* lds, int wave, int lane) {
    const int tid = fresh_tid();
    const f16* WINB = (const f16*)(a.ws() + WS_WINB); f16* CV = (f16*)(a.ws() + WS_CV); f16* SCB = (f16*)(a.ws() + WS_SCB);
    const int seq0 = (u < 4) ? 0 : CTX, seq1 = (u < 4) ? CTX : T, r0 = (u < 4) ? 64 * u : CTX + 64 * (u - 4);
    LAS f16* tile = (LAS f16*)lds;
    LAS float* co = (LAS float*)(lds + 49152);
    for (int idx = tid; idx < 94 * 32; idx += NTHR) { const int lr = idx >> 5, c8 = idx & 31, r = r0 - 15 + lr;
        h16x8 o;
#pragma unroll
        for (int i = 0; i < 8; ++i) o[i] = (f16)0.f;
        if (r >= seq0 && r < seq1) { const h16x8 a1 = *(const h16x8*)(WINB + (size_t)r * INW + C_CG + c8 * 8), a2 = *(const h16x8*)(WINB + (size_t)r * INW + C_CG + 256 + c8 * 8);
#pragma unroll
            for (int i = 0; i < 8; ++i) o[i] = (f16)((float)a1[i] * sigm_f((float)a2[i])); }
        *(LAS h16x8*)(tile + lr * 256 + c8 * 8) = o; }
    __syncthreads();
    { const int c = tid & 255, half = tid >> 8; float w[31];
#pragma unroll
      for (int t = 0; t < 31; ++t) w[t] = a.in(I_CDW)[(size_t)(l * 31 + t) * 256 + c];
      const float bias = a.in(I_CDB)[l * 256 + c];
#pragma unroll 2
      for (int o = 0; o < 32; ++o) { float acc = bias; const LAS f16* tp = tile + (half * 32 + o) * 256 + c;
#pragma unroll
          for (int t = 0; t < 31; ++t) acc += (float)tp[t * 256] * w[t];
          co[(half * 32 + o) * 256 + c] = acc; } }
    __syncthreads();
    { const f32x4 lg = *(const f32x4*)(a.in(I_CLG) + l * 256 + 4 * lane), lb = *(const f32x4*)(a.in(I_CLB) + l * 256 + 4 * lane);
#pragma unroll 1
      for (int tt = 0; tt < 8; ++tt) { const int tok = wave * 8 + tt; const f32x4 v = *(const LAS f32x4*)(co + tok * 256 + 4 * lane);
          const float mean = wave_sum((v.x + v.y) + (v.z + v.w)) * (1.0f / 256.0f); const f32x4 d = v - mean;
          const float var = wave_sum((d.x * d.x + d.y * d.y) + (d.z * d.z + d.w * d.w)) * (1.0f / 256.0f); const float rstd = 1.0f / sqrtf(var + EPS);
          f32x4 y = d * rstd * lg + lb; y.x = silu_f(y.x); y.y = silu_f(y.y); y.z = silu_f(y.z); y.w = silu_f(y.w);
          u32x2 w; w.x = pk2h(y.x, y.y); w.y = pk2h(y.z, y.w); *(u32x2*)(CV + (size_t)(r0 + tok) * 256 + 4 * lane) = w; } }
    for (int idx = tid; idx < 64 * 32; idx += NTHR) { const int lr = idx >> 5, c8 = idx & 31, r = r0 + lr; float acc[8];
#pragma unroll
        for (int i = 0; i < 8; ++i) acc[i] = 0.f;
#pragma unroll
        for (int t = 0; t < 3; ++t) { const int rr = r + t - 1; if (rr >= seq0 && rr < seq1) {
            const h16x8 gc = *(const h16x8*)(WINB + (size_t)rr * INW + C_SC + 256 + c8 * 8), hh = *(const h16x8*)(WINB + (size_t)rr * INW + C_SC + 512 + c8 * 8);
            const float* wp = a.in(I_SCW) + (size_t)(l * 3 + t) * 256 + c8 * 8;
#pragma unroll
            for (int i = 0; i < 8; ++i) acc[i] += (float)gc[i] * (float)hh[i] * wp[i]; } }
        const h16x8 gb = *(const h16x8*)(WINB + (size_t)r * INW + C_SC + c8 * 8);
        u32x4 w; w.x = pk2h((float)gb[0] * acc[0], (float)gb[1] * acc[1]); w.y = pk2h((float)gb[2] * acc[2], (float)gb[3] * acc[3]);
        w.z = pk2h((float)gb[4] * acc[4], (float)gb[5] * acc[5]); w.w = pk2h((float)gb[6] * acc[6], (float)gb[7] * acc[7]);
        *(u32x4*)(SCB + (size_t)r * 256 + c8 * 8) = w; }
    __syncthreads();
}
template <int K, class Epi>
__device__ __forceinline__ void dft_unit(LAS unsigned char* lds, const f16* gsrc, size_t rstride, const f16* Dm, const Epi& E) {
    constexpr int LPB = 516;
    const int tid = fresh_tid(), lane = tid & 63, wave = tid >> 6, fr = lane & 15, fq = lane >> 4;
    for (int i = tid; i < K * 32; i += NTHR) { const int row = i >> 5, pc = i & 31; const u32x4 v = *(const u32x4*)(gsrc + (size_t)row * rstride + pc * 8);
        LAS unsigned* d = (LAS unsigned*)(lds + row * LPB + pc * 16); d[0] = v.x; d[1] = v.y; d[2] = v.z; d[3] = v.w; }
    __syncthreads();
    const int cbase = wave * 32;
    h16x8 df[2][K / 32];
#pragma unroll
    for (int ct = 0; ct < 2; ++ct)
#pragma unroll
        for (int ks = 0; ks < K / 32; ++ks)
#pragma unroll
            for (int e = 0; e < 8; ++e) df[ct][ks][e] = *(const LAS f16*)(lds + (ks * 32 + fq * 8 + e) * LPB + (cbase + ct * 16 + fr) * 2);
#pragma unroll 1
    for (int j = 0; j < 8; ++j) {
        f32x4 acc[2][2];
#pragma unroll
        for (int rt = 0; rt < 2; ++rt)
#pragma unroll
            for (int ct = 0; ct < 2; ++ct) acc[rt][ct] = (f32x4){0.f, 0.f, 0.f, 0.f};
#pragma unroll
        for (int rt = 0; rt < 2; ++rt)
#pragma unroll
            for (int ks = 0; ks < K / 32; ++ks) { const h16x8 dm = *(const h16x8*)(Dm + (size_t)(rt * 128 + j * 16 + fr) * K + ks * 32 + fq * 8);
#pragma unroll
                for (int ct = 0; ct < 2; ++ct) acc[rt][ct] = __builtin_amdgcn_mfma_f32_16x16x32_f16(df[ct][ks], dm, acc[rt][ct], 0, 0, 0); }
#pragma unroll
        for (int ct = 0; ct < 2; ++ct) E(j * 16 + fr, cbase + ct * 16 + 4 * fq, acc[0][ct], acc[1][ct]);
    }
    __syncthreads();
}
__device__ __forceinline__ void st4h(f16* p, f32x4 v) { u32x2 w; w.x = pk2h(v.x, v.y); w.y = pk2h(v.z, v.w); *(u32x2*)p = w; }
struct EpiB1 { f16* AP; int n2;
    __device__ __forceinline__ void operator()(int k1, int c, f32x4 re, f32x4 im) const {
        float sn, cs; sincos_turns((float)((k1 * n2) & 16383) * (1.0f / 16384.0f), &sn, &cs);
        const f32x4 ar = re * cs + im * sn, ai = im * cs - re * sn;
        f16* p = AP + ((size_t)(k1 * 128 + n2) * 2) * 256 + c; st4h(p, ar); st4h(p + 256, ai); } };
struct EpiB2 { f16* FO; int k1;
    __device__ __forceinline__ void operator()(int k2, int c, f32x4 re, f32x4 im) const {
        f16* p = FO + (size_t)(CTX + k1 + 128 * k2) * 512 + c; st4h(p, re); st4h(p + 256, im); } };
struct EpiDC { f16* FO; int h;
    __device__ __forceinline__ void operator()(int kk, int c, f32x4 re, f32x4 im) const {
        f16* p = FO + (size_t)(128 * h + kk) * 512 + c; st4h(p, re); st4h(p + 256, im); } };

template <class Epi> __device__ __forceinline__ void run_gemm(LAS unsigned char* lds, const f16* A, const f16* Bt, int M, int N, int K, const Epi& E) {
    pg8::Gemm g{(const pg8::bf16_t*)A, (const pg8::bf16_t*)Bt, M, N, K}; pg8::StaticOrder S; S.init(M, N, (int)gridDim.x, (int)blockIdx.x);
    pg8::gemm_phase<Epi, pg8::StaticOrder, true, true>(lds, g, S, E);
}

#define FRESH() const KP a = fresh_kp(); const int tid = fresh_tid(); const int lane = tid & 63; const int wave = __builtin_amdgcn_readfirstlane(tid >> 6); \
    const int gw = bx * NWAVES + wave; unsigned char* const ws = a.ws(); (void)lane; (void)gw; (void)ws
__global__ void __launch_bounds__(NTHR, 2) fwd_megakernel(Args a_unused) {
    extern __shared__ __attribute__((aligned(16))) unsigned char lds_raw[];
    cg::grid_group grid = cg::this_grid();
    LAS unsigned char* lds = (LAS unsigned char*)lds_raw;
    const int G = gridDim.x, bx = blockIdx.x;
    const int vcu = (G % 8 == 0) ? (bx % 8) * (G / 8) + bx / 8 : bx;
    const int NGW = G * NWAVES;
    {
        FRESH();
        if (tid < 64) { float sn, cs; sincos_turns((float)tid * (1.0f / 64.0f), &sn, &cs); LAS float* ctab = (LAS float*)(lds + LDS_TAB); ctab[tid] = cs; ctab[64 + tid] = sn; }
        if (tid < 2) ((LAS unsigned*)(lds + LDS_BARST))[tid] = 0u;
        if (bx == 0) for (int i = tid; i < XCD_BAR_WORDS; i += NTHR) ((unsigned*)(ws + WS_BAR))[i] = 0u;
        __syncthreads();
#ifndef NO_P0
        phase0(a, lds, gw, NGW, wave, lane);
#endif
    }
    grid.sync();
    XcdBarrier xbar;
    { FRESH(); xbar = xcd_barrier_post((unsigned*)(ws + WS_BAR), (volatile LAS unsigned*)(lds + LDS_BARST)); }


#pragma unroll 1
    for (int l = 0; l < DEPTH; ++l) {
#pragma unroll 1
        for (int half = 0; half < 2; ++half) {
            const int slot = 2 * half;
            {
                FRESH();
                if (half == 0 && l > 0) convert_weights(a, l, lds, gw, NGW, wave, lane);
                norm_phase(a, l, slot, gw, NGW, lane);
            }
            xcd_barrier(xbar);
#ifndef NO_G1
            {
                FRESH();
                pg8::EpiSwiGLU E{(pg8::bf16_t*)(ws + WS_WINB), DFF};
                run_gemm(lds, (const f16*)(ws + WS_H), (const f16*)(ws + WS_W) + OFF_W13 + half * W13_E, T, 2 * DFF, DMODEL, E);
            }
#endif
            xcd_barrier(xbar);
#ifndef NO_G2
            {
                FRESH();
                const float* MOD = (const float*)(ws + WS_MOD);
                pg8::EpiResidual E{(float*)(ws + WS_X), MOD + (size_t)(l * 2 + 0) * 9216 + (3 * slot + 2) * 1024, MOD + (size_t)(l * 2 + 1) * 9216 + (3 * slot + 2) * 1024, 0.5f};
                run_gemm(lds, (const f16*)(ws + WS_WINB), (const f16*)(ws + WS_W) + OFF_W2 + half * W2_E, T, DMODEL, DFF, E);
            }
#endif
            xcd_barrier(xbar);
            if (half == 1) break;
            {
                FRESH();
                norm_phase(a, l, 1, gw, NGW, lane);
            }
            xcd_barrier(xbar);
#ifndef NO_G3
            {
                FRESH();
                pg8::EpiStoreF16 E{(pg8::bf16_t*)(ws + WS_WINB), INW};
                run_gemm(lds, (const f16*)(ws + WS_H), (const f16*)(ws + WS_W) + OFF_WIN, T, INW, DMODEL, E);
            }
#endif
            xcd_barrier(xbar);
#pragma unroll 1
            for (int u = bx; u < 260 + 128 + 2; u += G) {
                FRESH();
                const f16* WINB = (const f16*)(ws + WS_WINB);
#ifndef NO_CONV
                if (u < 260) conv_unit(a, l, u, lds, wave, lane); else
#endif
#ifndef NO_DFT
                if (u < 388) { const int n2 = u - 260; EpiB1 E{(f16*)(ws + WS_AP), n2}; dft_unit<128>(lds, WINB + (size_t)(CTX + n2) * INW + C_F, (size_t)128 * INW, (const f16*)(ws + WS_D1), E); }
                else { const int h = u - 388; EpiDC E{(f16*)(ws + WS_FO), h}; dft_unit<256>(lds, WINB + C_F, (size_t)INW, (const f16*)(ws + WS_DC) + (size_t)h * 65536, E); }
#endif
                {}
            }
#ifndef NO_QKV
            {
                FRESH();
                qkv_prep(a, l, gw, NGW, lane);
            }
#endif
            xcd_barrier(xbar);
#pragma unroll 1
            for (int idx = vcu; idx < 512 + 8 + 128; idx += G) {
                FRESH();
                const attn_body::bf16* QB = (const attn_body::bf16*)(ws + WS_QB); const attn_body::bf16* KB = (const attn_body::bf16*)(ws + WS_KB); const attn_body::bf16* VB = (const attn_body::bf16*)(ws + WS_VB);
                attn_body::bf16* AO = (attn_body::bf16*)(ws + WS_AO);
#ifndef NO_ATTN
                if (idx < 512) { const int v = idx & 255; attn_body::attn_unit<8>(v >> 5, 1 + 2 * (v & 31) + (idx >> 8), T / 64, QB, KB, VB, AO, (char*)lds_raw); }
                else if (idx < 520) { attn_body::attn_unit<8>(idx - 512, 0, CTX / 64, QB, KB, VB, AO, (char*)lds_raw); }
                else
#endif
#ifndef NO_DFT2
                { const int k1 = idx - 520; EpiB2 E{(f16*)(ws + WS_FO), k1}; dft_unit<256>(lds, (const f16*)(ws + WS_AP) + (size_t)k1 * 65536, (size_t)256, (const f16*)(ws + WS_D2), E); }
#endif
                {}
            }
            xcd_barrier(xbar);
#ifndef NO_G4
#pragma unroll 1
            for (int b = 0; b < 4; ++b) {
                FRESH();
                const f16* Ab = (const f16*)(ws + ((b == 0) ? WS_AO : (b == 1) ? WS_FO : (b == 2) ? WS_CV : WS_SCB));
                const f16* Wb = (const f16*)(ws + WS_W) + ((b == 0) ? OFF_WA : (b == 1) ? OFF_WF : (b == 2) ? OFF_WC : OFF_WS);
                const int Kb = (b < 2) ? 512 : 256;
                pg8::EpiGate E{(const pg8::bf16_t*)(ws + WS_WINB) + C_G + b * 1024, INW, a.in(I_BGATE) + (size_t)l * 4096 + b * 1024, (float*)(ws + WS_M32), (pg8::bf16_t*)(ws + WS_MH), b == 0, b == 3};
                run_gemm(lds, Ab, Wb, T, DMODEL, Kb, E);
            }
#endif
            xcd_barrier(xbar);
#ifndef NO_G5
            {
                FRESH();
                const float* MOD = (const float*)(ws + WS_MOD);
                pg8::EpiResidual E{(float*)(ws + WS_X), MOD + (size_t)(l * 2 + 0) * 9216 + 5 * 1024, MOD + (size_t)(l * 2 + 1) * 9216 + 5 * 1024, 1.0f};
                run_gemm(lds, (const f16*)(ws + WS_MH), (const f16*)(ws + WS_W) + OFF_WO, T, DMODEL, DMODEL, E);
            }
#endif
            xcd_barrier(xbar);
        }
    }
    {
        FRESH();
        final_norm(a, gw, NGW, lane);
    }
}

extern "C" void kernel_launch(void* const* d_in, const int* in_sizes, int n_in, void* d_out, int out_size, void* d_ws, size_t ws_size, hipStream_t stream) {
    static int grid = 0;
    if (grid == 0) {
        if (n_in != N_IN || out_size != SEQ * DMODEL || ws_size < WS_END) { fprintf(stderr, "kernel_launch: unexpected shapes (n_in %d out %d ws %zu)\n", n_in, out_size, ws_size); grid = -1; return; }
        int dev = 0, cus = 0, per_cu = 0;
        if (hipGetDevice(&dev) != hipSuccess || hipDeviceGetAttribute(&cus, hipDeviceAttributeMultiprocessorCount, dev) != hipSuccess) { grid = -1; return; }
        if (hipFuncSetAttribute((const void*)fwd_megakernel, hipFuncAttributeMaxDynamicSharedMemorySize, LDS_BYTES) != hipSuccess) { fprintf(stderr, "kernel_launch: hipFuncSetAttribute failed\n"); grid = -1; return; }
        if (hipOccupancyMaxActiveBlocksPerMultiprocessor(&per_cu, (const void*)fwd_megakernel, NTHR, LDS_BYTES) != hipSuccess || per_cu < 1) { fprintf(stderr, "kernel_launch: occupancy query says %d\n", per_cu); per_cu = 1; }
        (void)hipGetLastError();
        grid = cus * per_cu;
    }
    if (grid < 0) return;
    Args a{};
    for (int i = 0; i < N_IN; ++i) a.in[i] = (const float*)d_in[i];
    a.out = (float*)d_out; a.ws = (unsigned char*)d_ws;
    void* args[] = {&a};
    hipError_t e = hipLaunchCooperativeKernel((const void*)fwd_megakernel, dim3(grid), dim3(NTHR), args, LDS_BYTES, stream);
    if (e != hipSuccess) fprintf(stderr, "kernel_launch: cooperative launch failed: %s (grid %d)\n", hipGetErrorString(e), grid);
}
```

```cpp
#include <hip/hip_runtime.h>
#include <hip/hip_cooperative_groups.h>
#include <cstdio>
#include <cstdint>
namespace cg = cooperative_groups;

__device__ __forceinline__ int fresh_tid() { int t = (int)threadIdx.x; asm volatile("" : "+v"(t)); return t; }
typedef const __attribute__((address_space(4))) unsigned char* kargp_t;
struct KP {
    kargp_t kp;
    __device__ __forceinline__ const float* in(int i) const { return *(const float* const __attribute__((address_space(4)))*)(kp + 8 * i); }
    __device__ __forceinline__ float* out() const { return *(float* const __attribute__((address_space(4)))*)(kp + 8 * 24); }
    __device__ __forceinline__ unsigned char* ws() const { return *(unsigned char* const __attribute__((address_space(4)))*)(kp + 8 * 25); }
};
__device__ __forceinline__ KP fresh_kp() { KP p; p.kp = (kargp_t)__builtin_amdgcn_kernarg_segment_ptr(); asm volatile("" : "+s"(p.kp)); return p; }
namespace pg8 {
#define PG8_LAS __attribute__((address_space(3)))
typedef unsigned short bf16_t;
typedef _Float16 bf16x8 __attribute__((ext_vector_type(8)));
typedef float f32x4 __attribute__((ext_vector_type(4)));
typedef unsigned u32x4 __attribute__((ext_vector_type(4)));
constexpr int BM = 256, BK = 64, HALF = 128, HTB = HALF * BK * 2  , STAGE_BYTES = 8 * HTB, NXCD = 8, WGM = 8;

__host__ __device__ __forceinline__ int lds_byte(int r, int c) { const int st = (r >> 4) * 2 + (c >> 5), rr = r & 15, cc = c & 31, ob = rr * 64 + cc * 2; return st * 1024 + (ob ^ (((ob >> 9) & 1) << 5)); }
__host__ __device__ __forceinline__ void stage_rc(int b, int& R, int& C) { const int st = b / 1024, sb = b % 1024, swz = sb ^ (((sb >> 9) & 1) << 5); R = (st >> 1) * 16 + swz / 64; C = (st & 1) * 32 + (swz % 64) / 2; }
__host__ __device__ __forceinline__ int perm32(int rho) { const int n = rho >> 4, i = rho & 15; return 8 * (i >> 2) + 4 * n + (i & 3); }

struct Unit { int pm, pn, koff, nt, ks; };
struct Gemm { const bf16_t* A; const bf16_t* Bt; int M, N, K; };

struct StaticOrder {
    int nM, nN, nwg, G, c, nt0;
    __host__ __device__ void init(int M, int N, int G_, int c_) { nM = M / BM; nN = N / BM; nwg = nM * nN; G = G_; c = c_; }
    __host__ __device__ bool next(int i, Unit& u) const {
        const long L = (long)i * G + c; if (L >= nwg) return false;
        int wgid = (int)L; { const int q = nwg / NXCD, r = nwg % NXCD, xcd = wgid % NXCD, off = wgid / NXCD; wgid = (xcd < r ? xcd * (q + 1) : r * (q + 1) + (xcd - r) * q) + off; }
        const int nig = WGM * nN, gid = wgid / nig, fm = gid * WGM, gsz = (nM - fm) < WGM ? (nM - fm) : WGM;
        u.pm = fm + ((wgid % nig) % gsz); u.pn = (wgid % nig) / gsz; u.koff = 0; u.nt = nt0; u.ks = 0; return true;
    }
    __device__ __forceinline__ void a_ready(const Unit&) const {}
    __device__ __forceinline__ void done(const Unit&) const {}
};
typedef _Float16 h16x2e __attribute__((ext_vector_type(2)));
typedef unsigned u32x2 __attribute__((ext_vector_type(2)));
__device__ __forceinline__ unsigned pk2h(float lo, float hi) { h16x2e v; v.x = (_Float16)lo; v.y = (_Float16)hi; return __builtin_bit_cast(unsigned, v); }
__device__ __forceinline__ float silu_f(float a) { return a * __builtin_amdgcn_rcpf(1.0f + __expf(-a)); }
__device__ __forceinline__ float sigm_f(float a) { return __builtin_amdgcn_rcpf(1.0f + __expf(-a)); }

struct EpiStoreF16 {
    static constexpr bool PERM = true, AFTER_DRAIN = false;
    bf16_t* O; int ldc; unsigned char* G8; const float* bg;
    __device__ __forceinline__ void operator()(const f32x4 (&acc)[2][2][4][2], const Unit& u, int wr, int wc, int fr, int fq) const {
        const int row0 = u.pm * BM + wr * 64 + fr, col0 = u.pn * BM + wc * 32 + 8 * fq;
        if (u.pn >= 9) {
            const int g0 = col0 - 9 * BM; f32x4 bv[2][2];
#pragma unroll
            for (int bj = 0; bj < 2; ++bj)
#pragma unroll
                for (int n = 0; n < 2; ++n) bv[bj][n] = *(const f32x4*)(bg + g0 + bj * HALF + 4 * n);
#pragma unroll
            for (int ai = 0; ai < 2; ++ai)
#pragma unroll
                for (int m = 0; m < 4; ++m) { unsigned char* rowp = G8 + (size_t)(row0 + ai * HALF + m * 16) * 4096 + g0;
#pragma unroll
                    for (int bj = 0; bj < 2; ++bj) { u32x2 w; unsigned q[8];
#pragma unroll
                        for (int n = 0; n < 2; ++n)
#pragma unroll
                            for (int i = 0; i < 4; ++i) q[4 * n + i] = (unsigned)(sigm_f(acc[ai][bj][m][n][i] + bv[bj][n][i]) * 255.0f + 0.5f);
                        w.x = q[0] | (q[1] << 8) | (q[2] << 16) | (q[3] << 24); w.y = q[4] | (q[5] << 8) | (q[6] << 16) | (q[7] << 24);
                        *(u32x2*)(rowp + bj * HALF) = w; } }
            return;
        }
#pragma unroll
        for (int ai = 0; ai < 2; ++ai)
#pragma unroll
            for (int m = 0; m < 4; ++m) { bf16_t* rowp = O + (size_t)(row0 + ai * HALF + m * 16) * ldc + col0;
#pragma unroll
                for (int bj = 0; bj < 2; ++bj) { const f32x4 v0 = acc[ai][bj][m][0], v1 = acc[ai][bj][m][1];
                    u32x4 w; w.x = pk2h(v0[0], v0[1]); w.y = pk2h(v0[2], v0[3]); w.z = pk2h(v1[0], v1[1]); w.w = pk2h(v1[2], v1[3]);
                    *(u32x4*)(rowp + bj * HALF) = w; } }
    }
};
struct EpiSwiGLU {
    static constexpr bool PERM = true, AFTER_DRAIN = false;
    bf16_t* O; int ldc;
    __device__ __forceinline__ void operator()(const f32x4 (&acc)[2][2][4][2], const Unit& u, int wr, int wc, int fr, int fq) const {
        const int row0 = u.pm * BM + wr * 64 + fr, col0 = u.pn * HALF + wc * 32 + 8 * fq;
#pragma unroll
        for (int ai = 0; ai < 2; ++ai)
#pragma unroll
            for (int m = 0; m < 4; ++m) { bf16_t* rowp = O + (size_t)(row0 + ai * HALF + m * 16) * ldc + col0;
                const f32x4 a0 = acc[ai][0][m][0], a1 = acc[ai][0][m][1], b0 = acc[ai][1][m][0], b1 = acc[ai][1][m][1];
                float r[8];
#pragma unroll
                for (int i = 0; i < 4; ++i) { r[i] = silu_f(a0[i]) * b0[i]; r[4 + i] = silu_f(a1[i]) * b1[i]; }
                u32x4 w; w.x = pk2h(r[0], r[1]); w.y = pk2h(r[2], r[3]); w.z = pk2h(r[4], r[5]); w.w = pk2h(r[6], r[7]);
                *(u32x4*)(rowp) = w; }
    }
};
struct EpiResidual {
    static constexpr bool PERM = true, AFTER_DRAIN = false;
    bf16_t* X; const float* sv_lat; const float* sv_ctx; float* part; float mul;
    __device__ __forceinline__ void operator()(const f32x4 (&acc)[2][2][4][2], const Unit& u, int wr, int wc, int fr, int fq) const {
        typedef _Float16 h16x8r __attribute__((ext_vector_type(8)));
        const float* sv = (u.pm == 0) ? sv_ctx : sv_lat;
        const int col0 = u.pn * BM + wc * 32 + 8 * fq;
        f32x4 s[2][2];
#pragma unroll
        for (int bj = 0; bj < 2; ++bj)
#pragma unroll
            for (int n = 0; n < 2; ++n) s[bj][n] = *(const f32x4*)(sv + col0 + bj * HALF + 4 * n) * mul;
        const bool slab = part && u.pm == 0;
#pragma unroll
        for (int aim = 0; aim < 4; ++aim) { const int ai = aim >> 1, m0 = (aim & 1) * 2;
            u32x4 xv[4][2];
            if (!slab) {
#pragma unroll
                for (int m = m0; m < m0 + 2; ++m) { const bf16_t* xp = X + (size_t)(u.pm * BM + ai * HALF + wr * 64 + m * 16 + fr) * 1024 + col0;
#pragma unroll
                    for (int bj = 0; bj < 2; ++bj) xv[m][bj] = *(const u32x4*)(xp + bj * HALF); } }
#pragma unroll
            for (int m = m0; m < m0 + 2; ++m) { const int rt = ai * HALF + wr * 64 + m * 16 + fr; bf16_t* xp = X + (size_t)(u.pm * BM + rt) * 1024 + col0;
#pragma unroll
                for (int bj = 0; bj < 2; ++bj) { const f32x4 d0 = s[bj][0] * acc[ai][bj][m][0], d1 = s[bj][1] * acc[ai][bj][m][1];
                    if (slab) { float* pp = part + ((size_t)u.ks * 256 + rt) * 1024 + col0 + bj * HALF; *(f32x4*)pp = d0; *(f32x4*)(pp + 4) = d1; }
                    else { const h16x8r xh = __builtin_bit_cast(h16x8r, xv[m][bj]); u32x4 w;
                        w.x = pk2h((float)xh[0] + d0[0], (float)xh[1] + d0[1]); w.y = pk2h((float)xh[2] + d0[2], (float)xh[3] + d0[3]);
                        w.z = pk2h((float)xh[4] + d1[0], (float)xh[5] + d1[1]); w.w = pk2h((float)xh[6] + d1[2], (float)xh[7] + d1[3]);
                        *(u32x4*)(xp + bj * HALF) = w; } } }
            asm volatile("" ::: "memory"); }
    }
};
struct EpiGate {
    static constexpr bool PERM = true, AFTER_DRAIN = false;
    const unsigned char* G; int ldg; float* S32; bf16_t* SH; float* part; int first, last;
    __device__ __forceinline__ void operator()(const f32x4 (&acc)[2][2][4][2], const Unit& u, int wr, int wc, int fr, int fq) const {
        typedef _Float16 h16x8e __attribute__((ext_vector_type(8)));
        const int col0 = u.pn * BM + wc * 32 + 8 * fq;
        const bool ctxu = u.pm == 0, rd = !first && !ctxu;
#pragma unroll
        for (int ai = 0; ai < 2; ++ai) {
            u32x2 gv[4][2]; u32x4 pv[4][2];
#pragma unroll
            for (int m = 0; m < 4; ++m) { const size_t row = (size_t)(u.pm * BM + ai * HALF + wr * 64 + m * 16 + fr);
#pragma unroll
                for (int bj = 0; bj < 2; ++bj) { const int c = col0 + bj * HALF; gv[m][bj] = *(const u32x2*)(G + row * ldg + c);
                    if (rd) pv[m][bj] = *(const u32x4*)(SH + row * 1024 + c); } }
#pragma unroll
            for (int m = 0; m < 4; ++m) { const size_t row = (size_t)(u.pm * BM + ai * HALF + wr * 64 + m * 16 + fr);
#pragma unroll
                for (int bj = 0; bj < 2; ++bj) { const int c = col0 + bj * HALF; float v[8];
#pragma unroll
                    for (int n = 0; n < 2; ++n)
#pragma unroll
                        for (int i = 0; i < 4; ++i) { const unsigned gw = n ? gv[m][bj].y : gv[m][bj].x; v[4 * n + i] = (float)((gw >> (8 * i)) & 255u) * (1.0f / 255.0f) * acc[ai][bj][m][n][i]; }
                    if (ctxu) { *(f32x4*)(part + row * 1024 + c) = (f32x4){v[0], v[1], v[2], v[3]}; *(f32x4*)(part + row * 1024 + c + 4) = (f32x4){v[4], v[5], v[6], v[7]}; continue; }
                    if (rd) { const h16x8e ph = __builtin_bit_cast(h16x8e, pv[m][bj]);
#pragma unroll
                        for (int i = 0; i < 8; ++i) v[i] += (float)ph[i]; }
                    u32x4 w; w.x = pk2h(v[0], v[1]); w.y = pk2h(v[2], v[3]); w.z = pk2h(v[4], v[5]); w.w = pk2h(v[6], v[7]);
                    *(u32x4*)(SH + row * 1024 + c) = w; } }
            asm volatile("" ::: "memory"); }
    }
};


struct CtxSplitOrder {
    int G, c, ntf, S, coff;
    __host__ __device__ void init(int K, int S_, int G_, int c_, int coff_) { G = G_; c = c_; ntf = K / BK; S = S_; coff = coff_; }
    __host__ __device__ __forceinline__ bool next(int i, Unit& u) const {
        const int L = i * G + c, j = L - 256 - coff, xcd = L & 7, off = L >> 3, nts = ntf / S; const bool lat = L < 256;
        u.pm = lat ? 1 + xcd * 8 + (off & 7) : 0; u.pn = lat ? (off >> 3) : (j & 3); u.nt = lat ? ntf : nts; u.ks = lat ? 0 : (j >> 2); u.koff = u.ks * nts * BK;
        return lat || (j >= 0 && j < 4 * S);
    }
    __device__ __forceinline__ void a_ready(const Unit&) const {}
    __device__ __forceinline__ void done(const Unit&) const {}
};


template <class Epi, class Sched, bool ALIGN_EPI = false, bool SP2 = false>
__device__ __forceinline__ void gemm_phase(PG8_LAS unsigned char* lds, const Gemm g, const Sched& S, const Epi& E) {
    const int tid = fresh_tid(), wid = __builtin_amdgcn_readfirstlane(tid >> 6), lane = tid & 63, wr = wid >> 2, wc = wid & 3, fr = lane & 15, fq = lane >> 4;
    const int K = g.K;
    unsigned voffA[2], voffB[2];
#pragma unroll
    for (int i = 0; i < 2; ++i) { int R, C; stage_rc(tid * 16 + i * 8192, R, C); const int Rb = Epi::PERM ? ((R & ~31) + perm32(R & 31)) : R;
        voffA[i] = (unsigned)(R * K + C) * 2u; voffB[i] = (unsigned)(Rb * K + C) * 2u; }
    const size_t kstep = (size_t)(BK * 2);
    const size_t hstep = (size_t)HALF * K * 2;
    const size_t tstep = 2 * hstep;
    const unsigned ldsw = (unsigned)wid * 1024u;
    const int aoff = lds_byte(wr * 64 + fr, fq * 8), boff = lds_byte(wc * 32 + fr, fq * 8);
#define PG8_SA(b, h) (((b) * 2 + (h)) * HTB)
#define PG8_SB(b, h) ((4 + (b) * 2 + (h)) * HTB)
#define PG8_STAGE(bufoff, gbase, voff) do { _Pragma("unroll") for (int _i = 0; _i < 2; ++_i) \
        __builtin_amdgcn_global_load_lds((const unsigned*)((const char*)(gbase) + (voff)[_i]), (PG8_LAS unsigned*)(lds + (bufoff) + ldsw + _i * 8192), 16, 0, 0); } while (0)
#define PG8_LDA(dst, b, h) do { _Pragma("unroll") for (int m = 0; m < 4; ++m) _Pragma("unroll") for (int k = 0; k < 2; ++k) dst[m][k] = *(const PG8_LAS bf16x8*)(lds + PG8_SA(b, h) + aoff + m * 2048 + k * 1024); } while (0)
#define PG8_LDB(dst, b, h) do { _Pragma("unroll") for (int n = 0; n < 2; ++n) _Pragma("unroll") for (int k = 0; k < 2; ++k) dst[n][k] = *(const PG8_LAS bf16x8*)(lds + PG8_SB(b, h) + boff + n * 2048 + k * 1024); } while (0)
#define PG8_MMA(ai, bj, At, Bt) do { __builtin_amdgcn_s_setprio(1); _Pragma("unroll") for (int m = 0; m < 4; ++m) _Pragma("unroll") for (int n = 0; n < 2; ++n) _Pragma("unroll") for (int k = 0; k < 2; ++k) \
        acc[ai][bj][m][n] = __builtin_amdgcn_mfma_f32_16x16x32_f16(Bt[n][k], At[m][k], acc[ai][bj][m][n], 0, 0, 0); __builtin_amdgcn_s_setprio(0); } while (0)
#define PG8_WAIT_V(n) asm volatile("s_waitcnt vmcnt(" #n ")" ::: "memory")
#define PG8_WAIT_L(n) asm volatile("s_waitcnt lgkmcnt(" #n ")" ::: "memory")
#define PG8_BAR __builtin_amdgcn_s_barrier()
#define PG8_SCHED __builtin_amdgcn_sched_barrier(0)
    Unit cur, nxt; int ui = 0;
    if (!S.next(0, cur)) return;
    f32x4 acc[2][2][4][2];
#pragma unroll
    for (int a = 0; a < 2; ++a)
#pragma unroll
        for (int b = 0; b < 2; ++b)
#pragma unroll
            for (int m = 0; m < 4; ++m)
#pragma unroll
                for (int n = 0; n < 2; ++n) acc[a][b][m][n] = (f32x4){0.f, 0.f, 0.f, 0.f};
    bf16x8 At[4][2], B0[2][2], B1[2][2];
    const char* cA = (const char*)g.A + (size_t)cur.pm * tstep + (size_t)cur.koff * 2; const char* cB = (const char*)g.Bt + (size_t)cur.pn * tstep + (size_t)cur.koff * 2;
    S.a_ready(cur);
    if constexpr (SP2) {
        PG8_STAGE(PG8_SB(0, 0), cB, voffB); PG8_STAGE(PG8_SB(0, 1), cB + hstep, voffB); PG8_STAGE(PG8_SA(0, 0), cA, voffA); PG8_STAGE(PG8_SA(0, 1), cA + hstep, voffA);
        if (wr == 1) PG8_BAR;
        PG8_WAIT_V(2); PG8_BAR;
        PG8_STAGE(PG8_SB(1, 0), cB + kstep, voffB); PG8_STAGE(PG8_SA(1, 0), cA + kstep, voffA); PG8_STAGE(PG8_SB(1, 1), cB + hstep + kstep, voffB);
        PG8_WAIT_V(6); PG8_BAR;
    } else {
        PG8_STAGE(PG8_SB(0, 0), cB, voffB); PG8_STAGE(PG8_SA(0, 0), cA, voffA); PG8_STAGE(PG8_SB(0, 1), cB + hstep, voffB); PG8_STAGE(PG8_SA(0, 1), cA + hstep, voffA);
        if (wr == 1) PG8_BAR;
        PG8_WAIT_V(4); PG8_BAR;
        PG8_STAGE(PG8_SB(1, 0), cB + kstep, voffB); PG8_STAGE(PG8_SA(1, 0), cA + kstep, voffA); PG8_STAGE(PG8_SB(1, 1), cB + hstep + kstep, voffB);
        PG8_WAIT_V(6); PG8_BAR;
    }
    for (;;) {
        const bool has_next = S.next(ui + 1, nxt);
        const char* nA = has_next ? (const char*)g.A + (size_t)nxt.pm * tstep + (size_t)nxt.koff * 2 : cA; const char* nB = has_next ? (const char*)g.Bt + (size_t)nxt.pn * tstep + (size_t)nxt.koff * 2 : cB;
        const int nt = cur.nt;
        for (int t = 0; t < nt; t += 2) {
            const bool last = (t == nt - 2);
            const char* a1 = cA + (size_t)(t + 1) * kstep;
            const char* a2 = last ? nA : cA + (size_t)(t + 2) * kstep; const char* b2 = last ? nB : cB + (size_t)(t + 2) * kstep;
            const char* a3 = a2 + kstep; const char* b3 = b2 + kstep;
            if (last && has_next) S.a_ready(nxt);
            if constexpr (SP2) {
            PG8_LDB(B0, 0, 0); PG8_LDB(B1, 0, 1); PG8_SCHED; PG8_LDA(At, 0, 0); PG8_STAGE(PG8_SA(1, 1), a1 + hstep, voffA);
            PG8_WAIT_V(8); PG8_WAIT_L(0); PG8_BAR; PG8_MMA(0, 0, At, B0); PG8_MMA(0, 1, At, B1); PG8_BAR; PG8_SCHED;
            PG8_LDA(At, 0, 1); PG8_STAGE(PG8_SB(0, 0), b2, voffB); PG8_STAGE(PG8_SB(0, 1), b2 + hstep, voffB); PG8_STAGE(PG8_SA(0, 0), a2, voffA);
            PG8_WAIT_V(8); PG8_WAIT_L(0); PG8_BAR; PG8_MMA(1, 0, At, B0); PG8_MMA(1, 1, At, B1); PG8_BAR; PG8_SCHED;
            PG8_LDB(B0, 1, 0); PG8_LDB(B1, 1, 1); PG8_SCHED; PG8_LDA(At, 1, 0); PG8_STAGE(PG8_SA(0, 1), a2 + hstep, voffA);
            PG8_WAIT_V(8); PG8_WAIT_L(0); PG8_BAR; PG8_MMA(0, 0, At, B0); PG8_MMA(0, 1, At, B1); PG8_BAR; PG8_SCHED;
            PG8_LDA(At, 1, 1); PG8_STAGE(PG8_SB(1, 0), b3, voffB); PG8_STAGE(PG8_SB(1, 1), b3 + hstep, voffB); PG8_STAGE(PG8_SA(1, 0), a3, voffA);
            PG8_WAIT_V(8); PG8_WAIT_L(0); PG8_BAR; PG8_MMA(1, 0, At, B0); PG8_MMA(1, 1, At, B1); PG8_BAR; PG8_SCHED;
            } else {
            PG8_LDB(B0, 0, 0); PG8_SCHED; PG8_LDA(At, 0, 0); PG8_STAGE(PG8_SA(1, 1), a1 + hstep, voffA);
            PG8_WAIT_L(8); PG8_BAR; PG8_WAIT_L(0); PG8_MMA(0, 0, At, B0); PG8_BAR; PG8_SCHED;
            PG8_LDB(B1, 0, 1); PG8_STAGE(PG8_SB(0, 0), b2, voffB);
            PG8_BAR; PG8_WAIT_L(0); PG8_MMA(0, 1, At, B1); PG8_BAR;
            PG8_LDA(At, 0, 1); PG8_STAGE(PG8_SA(0, 0), a2, voffA);
            PG8_BAR; PG8_WAIT_L(0); PG8_MMA(1, 0, At, B0); PG8_BAR; PG8_SCHED;
            PG8_STAGE(PG8_SB(0, 1), b2 + hstep, voffB);
            PG8_WAIT_V(6); PG8_BAR; PG8_MMA(1, 1, At, B1); PG8_BAR;
            PG8_LDB(B0, 1, 0); PG8_SCHED; PG8_LDA(At, 1, 0); PG8_STAGE(PG8_SA(0, 1), a2 + hstep, voffA);
            PG8_WAIT_L(8); PG8_BAR; PG8_WAIT_L(0); PG8_MMA(0, 0, At, B0); PG8_BAR; PG8_SCHED;
            PG8_LDB(B1, 1, 1); PG8_STAGE(PG8_SB(1, 0), b3, voffB);
            PG8_BAR; PG8_WAIT_L(0); PG8_MMA(0, 1, At, B1); PG8_BAR;
            PG8_LDA(At, 1, 1); PG8_STAGE(PG8_SA(1, 0), a3, voffA);
            PG8_BAR; PG8_WAIT_L(0); PG8_MMA(1, 0, At, B0); PG8_BAR; PG8_SCHED;
            PG8_STAGE(PG8_SB(1, 1), b3 + hstep, voffB);
            PG8_WAIT_V(6); PG8_BAR; PG8_MMA(1, 1, At, B1); PG8_BAR;
            }
        }
        if constexpr (ALIGN_EPI) { if (wr == 0) PG8_BAR; }
        if constexpr (!Epi::AFTER_DRAIN) { E(acc, cur, wr, wc, fr, fq); S.done(cur); }
        if (!has_next) break;
#pragma unroll
        for (int a = 0; a < 2; ++a)
#pragma unroll
            for (int b = 0; b < 2; ++b)
#pragma unroll
                for (int m = 0; m < 4; ++m)
#pragma unroll
                    for (int n = 0; n < 2; ++n) acc[a][b][m][n] = (f32x4){0.f, 0.f, 0.f, 0.f};
        cur = nxt; cA = nA; cB = nB; ++ui;
        if constexpr (ALIGN_EPI) { if (wr == 1) PG8_BAR; }
    }
    PG8_WAIT_V(0);
    if constexpr (!ALIGN_EPI) { if (wr == 0) PG8_BAR; }
    PG8_BAR;
    if constexpr (Epi::AFTER_DRAIN) { E.fused(acc, cur, wr, wc, fr, fq, lds, wid, lane); S.done(cur); }
#undef PG8_SA
#undef PG8_SB
#undef PG8_STAGE
#undef PG8_LDA
#undef PG8_LDB
#undef PG8_MMA
#undef PG8_WAIT_V
#undef PG8_WAIT_L
#undef PG8_BAR
#undef PG8_SCHED
}
}
#include <cmath>
namespace attn_body {
using bf16=_Float16;
using bf16x8=__attribute__((ext_vector_type(8)))short;
using s16x4=__attribute__((ext_vector_type(4)))short;
using f32x16=__attribute__((ext_vector_type(16)))float;
using u32x4=__attribute__((ext_vector_type(4)))unsigned;
constexpr int D=64,QP=512,KP=128;
constexpr int NW=8,QBLK=32,QB=QBLK*NW,KVBLK=64;
constexpr int ATTN_UNIT_ROWS=QB;
__device__ __forceinline__ int crow(int r,int hi){return (r&3)+8*(r>>2)+4*hi;}
#define SBAR() __builtin_amdgcn_sched_barrier(0)
__device__ __forceinline__ void cmask(f32x16&p0,f32x16&p1,int jb,int qrel,int hi){
  const float NEG=-INFINITY; int kb=64*jb+4*hi;
  #pragma unroll
  for(int r=0;r<16;++r){int kv=kb+(r&3)+8*(r>>2); if(kv>qrel)p0[r]=NEG; if(kv+32>qrel)p1[r]=NEG;}
}

constexpr int NSLOT=3, SLOTB=8192;
constexpr int LDS_K=0, LDS_V=NSLOT*SLOTB, LDS_WS=2*NSLOT*SLOTB, LDS_OST=LDS_WS+NW*64*4, LDS_BYTES=LDS_OST+NW*4096;
constexpr float C2=0.125f*1.4426950408889634f;
__device__ __forceinline__ void glds16(const void*gsrc,unsigned lds_dst){unsigned keep;
  asm volatile("s_mov_b32 %0, m0\n\ts_mov_b32 m0, %2\n\ts_nop 0\n\tglobal_load_lds_dwordx4 %1, off\n\ts_mov_b32 m0, %0":"=&s"(keep):"v"(gsrc),"s"(lds_dst):"memory");}
__device__ __forceinline__ float max3f(float a,float b,float c){float r;asm("v_max3_f32 %0, %1, %2, %3":"=v"(r):"v"(a),"v"(b),"v"(c));return r;}
__device__ __forceinline__ float max2f(float a,float b){float r;asm("v_max_f32_e32 %0, %1, %2":"=v"(r):"v"(a),"v"(b));return r;}
__device__ __forceinline__ float fadd_s(float a,float b){float r;asm("v_add_f32_e32 %0, %1, %2":"=v"(r):"v"(a),"v"(b));return r;}
__device__ __forceinline__ float fsub_s(float a,float b){float r;asm("v_sub_f32_e32 %0, %1, %2":"=v"(r):"v"(a),"v"(b));return r;}
typedef _Float16 h16x8_t __attribute__((ext_vector_type(8)));
__device__ __forceinline__ f32x16 mfma32h(bf16x8 a,bf16x8 b,f32x16 c,int,int,int){return __builtin_amdgcn_mfma_f32_32x32x16_f16(__builtin_bit_cast(h16x8_t,a),__builtin_bit_cast(h16x8_t,b),c,0,0,0);}
__device__ __forceinline__ unsigned cvtpk_s(float lo,float hi){return __builtin_bit_cast(unsigned,__builtin_amdgcn_cvt_pkrtz(lo,hi));}
#define WAIT_BAR(N) asm volatile("s_waitcnt vmcnt(" #N ") lgkmcnt(0)\n\ts_barrier":::"memory")

__device__ __forceinline__ void qkt(f32x16&p0,f32x16&p1,const char*Kslot,const bf16x8*qr,const f32x16&negm,int r32,int hi){
  const char*kb=Kslot+hi*1024+r32*16;
  #pragma unroll
  for(int d0=0;d0<4;++d0){
    const bf16x8 b0=*reinterpret_cast<const bf16x8*>(kb+d0*2048);
    const bf16x8 b1=*reinterpret_cast<const bf16x8*>(kb+d0*2048+512);
    if(d0==0){p0=mfma32h(b0,qr[0],negm,0,0,0);p1=mfma32h(b1,qr[0],negm,0,0,0);}
    else{p0=mfma32h(b0,qr[d0],p0,0,0,0);p1=mfma32h(b1,qr[d0],p1,0,0,0);}}
}
typedef __attribute__((address_space(3))) const char* lds_cptr;
typedef short v4i16_t __attribute__((ext_vector_type(4)));
__device__ __forceinline__ void kload8(bf16x8*kf,lds_cptr kp){
  kf[0]=*(const __attribute__((address_space(3))) bf16x8*)(kp);      kf[1]=*(const __attribute__((address_space(3))) bf16x8*)(kp+512);
  kf[2]=*(const __attribute__((address_space(3))) bf16x8*)(kp+2048); kf[3]=*(const __attribute__((address_space(3))) bf16x8*)(kp+2560);
  kf[4]=*(const __attribute__((address_space(3))) bf16x8*)(kp+4096); kf[5]=*(const __attribute__((address_space(3))) bf16x8*)(kp+4608);
  kf[6]=*(const __attribute__((address_space(3))) bf16x8*)(kp+6144); kf[7]=*(const __attribute__((address_space(3))) bf16x8*)(kp+6656);
}
__device__ __forceinline__ void kload2(bf16x8*kf,lds_cptr kp,int j){ kf[2*j]=*(const __attribute__((address_space(3))) bf16x8*)(kp+j*2048); kf[2*j+1]=*(const __attribute__((address_space(3))) bf16x8*)(kp+j*2048+512); }
__device__ __forceinline__ s16x4 vtr(lds_cptr p){ return __builtin_bit_cast(s16x4,__builtin_amdgcn_ds_read_tr16_b64_v4i16((__attribute__((address_space(3))) v4i16_t*)p)); }
__device__ __forceinline__ float rowmax(const f32x16&p0,const f32x16&p1){
  float a=max3f(p0[0],p0[1],p1[0]),b=max3f(p0[2],p0[3],p1[1]);a=max3f(a,p1[2],p1[3]);
  #pragma unroll
  for(int r=4;r<16;r+=4){a=max3f(a,p0[r],p0[r+1]);b=max3f(b,p0[r+2],p0[r+3]);a=max3f(a,p1[r],p1[r+1]);b=max3f(b,p1[r+2],p1[r+3]);}
  const float m=max2f(a,b);
  auto rr=__builtin_amdgcn_permlane32_swap(__float_as_uint(m),__float_as_uint(m),false,false);
  return max2f(__uint_as_float(rr[0]),__uint_as_float(rr[1]));
}
__device__ __forceinline__ void pv(f32x16*o,int vb,bf16x8 pa0,bf16x8 pa1,bf16x8 pa2,bf16x8 pa3){
  #pragma unroll
  for(int d0=0;d0<2;++d0){s16x4 lo[4],hi[4];
    #pragma unroll
    for(int ks=0;ks<4;++ks){
      asm volatile("ds_read_b64_tr_b16 %0,%1 offset:%c2":"=&v"(lo[ks]):"v"(vb),"i"(d0*4096+ks*1024):"memory");
      asm volatile("ds_read_b64_tr_b16 %0,%1 offset:%c2":"=&v"(hi[ks]):"v"(vb),"i"(d0*4096+ks*1024+512):"memory");}
    asm volatile("s_waitcnt lgkmcnt(0)":::"memory");SBAR();
    #define PK(k) (bf16x8){lo[k][0],lo[k][1],lo[k][2],lo[k][3],hi[k][0],hi[k][1],hi[k][2],hi[k][3]}
    o[d0]=mfma32h(pa0,PK(0),o[d0],0,0,0);
    o[d0]=mfma32h(pa1,PK(1),o[d0],0,0,0);
    o[d0]=mfma32h(pa2,PK(2),o[d0],0,0,0);
    o[d0]=mfma32h(pa3,PK(3),o[d0],0,0,0);
    #undef PK
  }
}

#ifndef ATTN_STORE16
#define ATTN_STORE16(p,v) (*(u32x4*)(p)=(v))
#endif
template<int THRL> __device__ __forceinline__ void attn_unit(int h,int qb,int NT,const bf16*Q,const bf16*__restrict__ K,const bf16*__restrict__ V,bf16*O,char*shm){
  const int tid=fresh_tid(),lane=tid&63,r32=lane&31,hi=lane>>5; const int wid=__builtin_amdgcn_readfirstlane(tid>>6);
  const int q0=qb*QB;
  const bf16*Qw=Q+(long)(q0+wid*QBLK)*QP+h*D;
  const bf16*Kh=K+(h>>2)*D,*Vh=V+(h>>2)*D;
  const unsigned lds0=(unsigned)(uintptr_t)shm;
  float*wsf=(float*)(shm+LDS_WS)+wid*64;
  const bf16*ksrc=Kh+(long)lane*KP+wid*8;
  const bf16*vsrc=Vh+(long)(16*(wid&3)+(lane>>2))*KP+(wid>>2)*32+(lane&3)*8;
  const unsigned kdst=lds0+LDS_K+wid*1024, vdst=lds0+LDS_V+wid*1024;
  #define DMA_K(t,slot) glds16(ksrc+(long)(t)*KVBLK*KP,(unsigned)__builtin_amdgcn_readfirstlane(kdst+(slot)))
  #define DMA_V(t,slot) glds16(vsrc+(long)(t)*KVBLK*KP,(unsigned)__builtin_amdgcn_readfirstlane(vdst+(slot)))
  const int vb0=(int)(lds0+LDS_V)+((lane>>4)&1)*32+(lane&3)*8+(4*hi+((lane&15)>>2))*64;
  const char*Kbase=shm+LDS_K; bf16x8 kf[8];
  const lds_cptr shm3=(lds_cptr)shm; const lds_cptr kp0=shm3+LDS_K+hi*1024+r32*16; const lds_cptr vp0=shm3+LDS_V+((lane>>4)&1)*32+(lane&3)*8+(4*hi+((lane&15)>>2))*64;
  DMA_K(0,0);DMA_V(0,0);DMA_K(1,SLOTB);
  bf16x8 qr[4];
  #pragma unroll
  for(int d0=0;d0<4;++d0)qr[d0]=*reinterpret_cast<const bf16x8*>(&Qw[(long)r32*QP+d0*16+hi*8]);
  float mhat=0.f,l_reg=0.f;f32x16 o[2];o[0]=f32x16{};o[1]=f32x16{};f32x16 negm=f32x16{};asm volatile("":"+v"(negm));
  const int qrel=wid*QBLK+r32;
  #define CMASK(P0,P1,t) do{}while(0)
  bool resc=false;
  #define START(P0,P1) do{ const float rm=rowmax(P0,P1); resc=false; \
    { const float dl=rm; mhat=fadd_s(mhat,dl); \
      _Pragma("unroll") for(int r=0;r<16;++r){P0[r]=fsub_s(P0[r],dl);P1[r]=fsub_s(P1[r],dl);} \
      _Pragma("unroll") for(int r=0;r<16;++r)negm[r]=-mhat; asm volatile("":"+v"(negm)); } \
    _Pragma("unroll") for(int r=0;r<16;++r)P0[r]=__builtin_amdgcn_exp2f(P0[r]); }while(0)
  #define RESC() do{ if(resc){ asm volatile("s_waitcnt lgkmcnt(0)":::"memory"); \
      _Pragma("unroll") for(int d_=0;d_<2;++d_) _Pragma("unroll") for(int r=0;r<16;++r)o[d_][r]*=wsf[crow(r,hi)]; } }while(0)
  f32x16 pA0,pA1,pB0,pB1;
  int sl_prev=0,sl_cur=0,sl_next=SLOTB;
  #define ROT() do{sl_prev=sl_cur;sl_cur=sl_next;sl_next=(sl_next==(NSLOT-1)*SLOTB)?0:sl_next+SLOTB;}while(0)
  DMA_K(2,2*SLOTB);
  WAIT_BAR(3);
  qkt(pA0,pA1,Kbase,qr,negm,r32,hi);asm volatile("s_nop 15\n\ts_nop 7":"+v"(pA0),"+v"(pA1));CMASK(pA0,pA1,0);
  START(pA0,pA1);
  _Pragma("unroll") for(int r=0;r<16;++r)pA1[r]=__builtin_amdgcn_exp2f(pA1[r]);
  WAIT_BAR(0);
  DMA_K(3,0);DMA_V(1,SLOTB);
  ROT();
  kload8(kf,kp0+sl_cur);
  WAIT_BAR(2);
  s16x4 vlo[8],vhi[8]; u32x4 pw0,pw1,pw2,pw3;
  #define PKW(P,B) cvtpk_s(P[B],P[B+1])
  #define PAF(k) __builtin_bit_cast(bf16x8,pw##k)
  #define VFR(i) (bf16x8){vlo[i][0],vlo[i][1],vlo[i][2],vlo[i][3],vhi[i][0],vhi[i][1],vhi[i][2],vhi[i][3]}
  #define PIN(x) asm volatile("":"+v"(x))
  #define MX3(a,b,c) __builtin_fmaxf(__builtin_fmaxf((a),(b)),(c))
  #define GAPA(MF,A0,A1,A2,A3,W0,W1,PW) do{ MF; sacc+=A0; sacc+=A1; sacc+=A2; sacc+=A3; PIN(sacc); W0; W1; PIN(PW); SBAR(); }while(0)
  #define EX(v) __builtin_amdgcn_exp2f(v)
  #define GAPB(MF,X,B) do{ MF; X[B]=EX(X[B]); X[B+1]=EX(X[B+1]); X[B+2]=EX(X[B+2]); X[B+3]=EX(X[B+3]); PIN(X); SBAR(); }while(0)
  #define VRD(i) do{ vlo[i]=vtr(vp_+(((i)>>2)*4096+((i)&3)*1024)); vhi[i]=vtr(vp_+(((i)>>2)*4096+((i)&3)*1024+512)); }while(0)
  #define KRD(G,j) do{ if(G){ kload2(kf,kp0+sl_next,j); SBAR(); } }while(0)
  #define STEP(C0,C1,P0,P1,t,GK,GV,GL) do{ SBAR(); \
    const lds_cptr vp_=vp0+sl_prev; \
    VRD(0); SBAR(); float sacc=(P0[0]+P0[1]); \
    GAPA(C0=mfma32h(kf[0],qr[0],negm,0,0,0), P0[2],P0[3],P0[4],P0[5],     pw0[0]=PKW(P0,0), pw0[1]=PKW(P0,2), pw0); \
    VRD(4); SBAR(); GAPA(C1=mfma32h(kf[1],qr[0],negm,0,0,0), P0[6],P0[7],P0[8],P0[9],     pw0[2]=PKW(P0,4), pw0[3]=PKW(P0,6), pw0); \
    VRD(1); SBAR(); GAPA(C0=mfma32h(kf[2],qr[1],C0,0,0,0),   P0[10],P0[11],P0[12],P0[13], pw1[0]=PKW(P0,8), pw1[1]=PKW(P0,10), pw1); \
    VRD(5); SBAR(); GAPA(C1=mfma32h(kf[3],qr[1],C1,0,0,0),   P0[14],P0[15],P1[0],P1[1],   pw1[2]=PKW(P0,12),pw1[3]=PKW(P0,14), pw1); \
    VRD(2); SBAR(); GAPA(C0=mfma32h(kf[4],qr[2],C0,0,0,0),   P1[2],P1[3],P1[4],P1[5],     pw2[0]=PKW(P1,0), pw2[1]=PKW(P1,2), pw2); \
    VRD(6); SBAR(); GAPA(C1=mfma32h(kf[5],qr[2],C1,0,0,0),   P1[6],P1[7],P1[8],P1[9],     pw2[2]=PKW(P1,4), pw2[3]=PKW(P1,6), pw2); \
    VRD(3); SBAR(); GAPA(C0=mfma32h(kf[6],qr[3],C0,0,0,0),   P1[10],P1[11],P1[12],P1[13], pw3[0]=PKW(P1,8), pw3[1]=PKW(P1,10), pw3); \
    VRD(7); SBAR(); GAPA(C1=mfma32h(kf[7],qr[3],C1,0,0,0),   P1[14],P1[15],0.f,0.f,       pw3[2]=PKW(P1,12),pw3[3]=PKW(P1,14), pw3); \
    l_reg+=sacc; \
    if(GK){DMA_K((t)+3,sl_cur);} if(GV){DMA_V((t)+1,sl_next);} \
    CMASK(C0,C1,t); \
    { float a=MX3(C0[0],C0[1],C1[0]),b=MX3(C0[2],C0[3],C1[1]); a=MX3(a,C1[2],C1[3]); \
      _Pragma("unroll") for(int r=4;r<16;r+=4){a=MX3(a,C0[r],C0[r+1]);b=MX3(b,C0[r+2],C0[r+3]);a=MX3(a,C1[r],C1[r+1]);b=MX3(b,C1[r+2],C1[r+3]);} \
      float rm=__builtin_fmaxf(a,b); { auto rr=__builtin_amdgcn_permlane32_swap(__float_as_uint(rm),__float_as_uint(rm),false,false); rm=__builtin_fmaxf(__uint_as_float(rr[0]),__uint_as_float(rr[1])); } \
      resc=false; \
      if(__builtin_expect(__any(rm>(float)THRL),0)){ const float dl=__builtin_fmaxf(rm,0.f); mhat+=dl; \
        _Pragma("unroll") for(int r=0;r<16;++r){C0[r]-=dl;C1[r]-=dl;} \
        _Pragma("unroll") for(int r=0;r<16;++r)negm[r]=-mhat; asm volatile("":"+v"(negm)); \
        const float f=__builtin_amdgcn_exp2f(-dl); l_reg*=f; if(hi==0)wsf[r32]=f; resc=true; } } \
    SBAR(); \
    GAPB(o[0]=mfma32h(PAF(0),VFR(0),o[0],0,0,0), C0,0); \
    GAPB(o[1]=mfma32h(PAF(0),VFR(4),o[1],0,0,0), C0,4); \
    KRD(GL,0); GAPB(o[0]=mfma32h(PAF(1),VFR(1),o[0],0,0,0), C0,8); \
    KRD(GL,1); GAPB(o[1]=mfma32h(PAF(1),VFR(5),o[1],0,0,0), C0,12); \
    KRD(GL,2); GAPB(o[0]=mfma32h(PAF(2),VFR(2),o[0],0,0,0), C1,0); \
    KRD(GL,3); GAPB(o[1]=mfma32h(PAF(2),VFR(6),o[1],0,0,0), C1,4); \
    GAPB(o[0]=mfma32h(PAF(3),VFR(3),o[0],0,0,0), C1,8); \
    GAPB(o[1]=mfma32h(PAF(3),VFR(7),o[1],0,0,0), C1,12); \
    }while(0)
  int t=1;
  #undef CMASK
  #define CMASK(P0,P1,t) do{}while(0)
  for(;t+5<NT;t+=2){
    STEP(pB0,pB1,pA0,pA1,t,true,true,true);     WAIT_BAR(2); RESC(); ROT();
    STEP(pA0,pA1,pB0,pB1,t+1,true,true,true);   WAIT_BAR(2); RESC(); ROT();
  }
  #undef CMASK
  #define CMASK(P0,P1,t) do{}while(0)
  #define ENDW(tt) do{ if((tt)+3<NT){WAIT_BAR(2);} else if((tt)+2<NT){WAIT_BAR(1);} else {WAIT_BAR(0);} }while(0)
  for(;t+1<NT;t+=2){
    STEP(pB0,pB1,pA0,pA1,t,(t+3<NT),(t+1<NT),(t+1<NT));       ENDW(t);   RESC(); ROT();
    STEP(pA0,pA1,pB0,pB1,t+1,(t+4<NT),(t+2<NT),(t+2<NT));     ENDW(t+1); RESC(); ROT();
  }
  STEP(pB0,pB1,pA0,pA1,NT-1,false,false,false); RESC();
  { float sacc=pB0[0]+pB0[1]; _Pragma("unroll") for(int r=2;r<16;++r)sacc+=pB0[r]; _Pragma("unroll") for(int r=0;r<16;++r)sacc+=pB1[r]; l_reg+=sacc;
    pw0=(u32x4){PKW(pB0,0),PKW(pB0,2),PKW(pB0,4),PKW(pB0,6)};pw1=(u32x4){PKW(pB0,8),PKW(pB0,10),PKW(pB0,12),PKW(pB0,14)};pw2=(u32x4){PKW(pB1,0),PKW(pB1,2),PKW(pB1,4),PKW(pB1,6)};pw3=(u32x4){PKW(pB1,8),PKW(pB1,10),PKW(pB1,12),PKW(pB1,14)};
    SBAR(); pv(o,vb0+sl_cur,PAF(0),PAF(1),PAF(2),PAF(3)); }
  #undef PKW
  #undef PAF
  #undef VFR
  #undef PIN
  #undef MX3
  #undef GAPA
  #undef GAPB
  #undef EX
  #undef VRD
  #undef KRD
  #undef STEP
  #undef ENDW
  {auto rr=__builtin_amdgcn_permlane32_swap(__float_as_uint(l_reg),__float_as_uint(l_reg),false,false);l_reg=__uint_as_float(rr[0])+__uint_as_float(rr[1]);}
  if(hi==0)wsf[32+r32]=l_reg;asm volatile("s_waitcnt lgkmcnt(0)":::"memory");
  float rli[16];
  #pragma unroll
  for(int r=0;r<16;++r)rli[r]=__builtin_amdgcn_rcpf(wsf[32+crow(r,hi)]);
  bf16*Ow=O+(long)(q0+wid*QBLK)*QP+h*D;
  { bf16*stg=(bf16*)(shm+LDS_OST)+wid*2048;
    #pragma unroll
    for(int r=0;r<16;++r){const int orow=crow(r,hi);
      #pragma unroll
      for(int d0=0;d0<2;++d0)stg[orow*64+d0*32+r32]=(_Float16)(o[d0][r]*rli[r]);}
    asm volatile("s_waitcnt lgkmcnt(0)":::"memory");
    #pragma unroll
    for(int i=0;i<4;++i){const int row=i*8+(lane>>3),ch=lane&7; const u32x4 v=*(const u32x4*)(stg+row*64+ch*8); ATTN_STORE16(Ow+(long)row*QP+ch*8,v);} }
  asm volatile("s_waitcnt lgkmcnt(0)\n\ts_barrier":::"memory");
  #undef DMA_K
  #undef DMA_V
  #undef CMASK
  #undef START
  #undef RESC
  #undef ROT
}
constexpr int ATTN_LDS_BYTES=LDS_BYTES;
#undef SBAR
#undef WAIT_BAR
}
#ifndef LAS
#define LAS __attribute__((address_space(3)))
#endif
#define XB_TMO      128
#define XB_XCNT(j)  (256  + 64 * (j))
#define XB_XSUB(j)  (1280 + 64 * (j))
#define XB_XGEN(j)  (2304 + 64 * (j))
#define XB_TOP      3328
#define XB_TOPGEN   3392
#define XCD_BAR_WORDS 3456
#define XB_SPIN_CAP (1u << 18)

__device__ __forceinline__ unsigned xb_ld(unsigned* p)              { return __hip_atomic_load(p, __ATOMIC_RELAXED, __HIP_MEMORY_SCOPE_AGENT); }
__device__ __forceinline__ unsigned xb_add(unsigned* p, unsigned v) { return __hip_atomic_fetch_add(p, v, __ATOMIC_RELAXED, __HIP_MEMORY_SCOPE_AGENT); }
__device__ __forceinline__ unsigned xb_xcc_id() { return (unsigned)__builtin_amdgcn_s_getreg((3 << 11) | 20) & 0xFu; }
#define XB_SPIN(cond, bar) do { unsigned _sp = 0; while (cond) { __builtin_amdgcn_s_sleep(1); \
    if ((++_sp & 255u) == 0u) { if (xb_ld(&(bar)[XB_TMO])) break; if (_sp > XB_SPIN_CAP) { atomicAdd(&(bar)[XB_TMO], 1u); break; } } } } while (0)

struct XcdBarrier {
    unsigned* bar; unsigned x;
    volatile LAS unsigned* st;
};

__device__ __forceinline__ XcdBarrier xcd_barrier_post(unsigned* bar, volatile LAS unsigned* st) {
    XcdBarrier b; b.bar = bar; b.x = xb_xcc_id(); b.st = st;
    if (threadIdx.x == 0) (void)xb_add(&bar[XB_XCNT(b.x)], 1u);
    return b;
}
__device__ __forceinline__ void xcd_barrier_complete(unsigned* bar, unsigned x, unsigned& nloc, unsigned& nx) {
    const unsigned G = gridDim.x * gridDim.y * gridDim.z;
    unsigned sum, cnt, mine, sp = 0u;
    for (;;) {
        sum = 0u; cnt = 0u; mine = 0u;
#pragma unroll
        for (unsigned j = 0; j < 16; ++j) { const unsigned c = xb_ld(&bar[XB_XCNT(j)]); sum += c; cnt += (c > 0u) ? 1u : 0u; mine = (j == x) ? c : mine; }
        if (sum == G) break;
        __builtin_amdgcn_s_sleep(1);
        if ((++sp & 255u) == 0u) { if (xb_ld(&bar[XB_TMO])) break; if (sp > XB_SPIN_CAP) { atomicAdd(&bar[XB_TMO], 1u); break; } }
    }
    nloc = mine > 0u ? mine : 1u; nx = cnt > 0u ? cnt : 1u;
}

__device__ __forceinline__ void xcd_barrier(const XcdBarrier& b) {
    asm volatile("s_waitcnt vmcnt(0)" ::: "memory");
    __syncthreads();
    if (threadIdx.x == 0) {
        unsigned* bar = b.bar;
        __builtin_amdgcn_s_waitcnt(0);
        unsigned nloc = b.st[0], nx = b.st[1];
        if (nloc == 0u) { xcd_barrier_complete(bar, b.x, nloc, nx); b.st[0] = nloc; b.st[1] = nx; }
        const unsigned old = xb_add(&bar[XB_XSUB(b.x)], 1u);
        const unsigned gen = old / nloc;
        if (old + 1u == (gen + 1u) * nloc) {
            __builtin_amdgcn_fence(__ATOMIC_RELEASE, "agent");
            asm volatile("s_waitcnt vmcnt(0)" ::: "memory");
            const unsigned og = xb_add(&bar[XB_TOP], 1u);
            const unsigned tg = og / nx;
            if (og + 1u == (tg + 1u) * nx) xb_add(&bar[XB_TOPGEN], 1u);
            else XB_SPIN(xb_ld(&bar[XB_TOPGEN]) == tg, bar);
            __builtin_amdgcn_fence(__ATOMIC_ACQUIRE, "agent");
            xb_add(&bar[XB_XGEN(b.x)], 1u);
            asm volatile("s_waitcnt vmcnt(0)" ::: "memory");
        } else {
            XB_SPIN(xb_ld(&bar[XB_XGEN(b.x)]) == gen, bar);
            __builtin_amdgcn_fence(__ATOMIC_ACQUIRE, "agent");
            asm volatile("s_waitcnt vmcnt(0)" ::: "memory");
        }
    }
    __syncthreads();
}
typedef _Float16 f16;
typedef _Float16 h16x8 __attribute__((ext_vector_type(8)));
typedef _Float16 h16x4 __attribute__((ext_vector_type(4)));
typedef float f32x4 __attribute__((ext_vector_type(4)));
typedef unsigned u32x4 __attribute__((ext_vector_type(4)));
typedef unsigned u32x2 __attribute__((ext_vector_type(2)));
using pg8::pk2h; using pg8::silu_f; using pg8::sigm_f;

constexpr int NWAVES = 8, NTHR = 512;
constexpr int DMODEL = 1024, SEQ = 16384, CTX = 256, T = SEQ + CTX, DEPTH = 4, DFF = 2816, INW = 6400, NMOD = 9;
constexpr int WP = 2304;
constexpr int C_Q = 0, C_K = 512, C_V = 640, C_F = 768, C_CG = 1024, C_SC = 1536, C_G = 2304;
constexpr float EPS = 1e-6f;
constexpr float QSCALE = 0.125f * 1.4426950408889634f;
enum { I_X = 0, I_C, I_CTX, I_CCTX, I_WADA, I_BADA, I_NORMG, I_W13, I_W2, I_WIN, I_BGATE, I_QNG, I_KNG, I_WAO, I_WFN, I_CDW, I_CDB, I_CLG, I_CLB, I_WCO, I_SCW, I_WSO, I_WO, I_FNG, N_IN };

constexpr size_t MiB = 1u << 20;
constexpr size_t WS_MOD = 1 * MiB;
constexpr size_t WS_D1 = 2 * MiB;
constexpr size_t WS_D2 = WS_D1 + 65536;
constexpr size_t WS_DC = WS_D2 + 131072;
constexpr size_t WS_W = 4 * MiB;
constexpr size_t W13_E = (size_t)2 * DFF * DMODEL;
constexpr size_t W2_E = (size_t)DMODEL * DFF;
constexpr size_t OFF_W13 = 0, OFF_W2 = OFF_W13 + 2 * W13_E, OFF_WIN = OFF_W2 + 2 * W2_E, OFF_WA = OFF_WIN + (size_t)INW * DMODEL,
                 OFF_WF = OFF_WA + 1024 * 512, OFF_WC = OFF_WF + 1024 * 512, OFF_WS = OFF_WC + 1024 * 256, OFF_WO = OFF_WS + 1024 * 256, W_TOTAL_E = OFF_WO + 1024 * 1024;
constexpr size_t WS_X = 56 * MiB;
constexpr size_t WS_H = 122 * MiB;
constexpr size_t WS_MH = 155 * MiB;
constexpr size_t WS_WINB = 188 * MiB;
constexpr size_t WS_G8 = 280 * MiB;
constexpr size_t WS_M32 = 392 * MiB;
constexpr size_t WS_QB = 458 * MiB;
constexpr size_t WS_AO = 475 * MiB;
constexpr size_t WS_FO = 492 * MiB;
constexpr size_t WS_KB = 509 * MiB;
constexpr size_t WS_VB = 514 * MiB;
constexpr size_t WS_CV = 519 * MiB;
constexpr size_t WS_SCB = 528 * MiB;
constexpr size_t WS_AP = 537 * MiB;
constexpr size_t WS_PART = 554 * MiB;
constexpr size_t WS_END = 566 * MiB;
static_assert(WS_W + W_TOTAL_E * 2 <= WS_X && WS_X + (size_t)T * 1024 * 4 <= WS_H && WS_H + (size_t)T * 2048 <= WS_MH && WS_MH + (size_t)T * 2048 <= WS_WINB &&
              WS_WINB + (size_t)T * DFF * 2 <= WS_G8 && WS_WINB + (size_t)T * WP * 2 <= WS_G8 && WS_G8 + (size_t)T * 4096 <= WS_M32 && WS_M32 + (size_t)T * 4096 <= WS_QB && WS_QB + (size_t)T * 1024 <= WS_AO && WS_AO + (size_t)T * 1024 <= WS_FO &&
              WS_FO + (size_t)T * 1024 <= WS_KB && WS_KB + (size_t)T * 256 <= WS_VB && WS_VB + (size_t)T * 256 <= WS_CV && WS_CV + (size_t)T * 512 <= WS_SCB &&
              WS_SCB + (size_t)T * 512 <= WS_AP && W_TOTAL_E * 2 <= (size_t)T * 4096 && WS_AP + 16 * MiB <= WS_PART && WS_PART + (size_t)11 * 256 * 4096 <= WS_END, "d_ws map");
constexpr int LDS_BYTES = 147456;
constexpr int LDS_TAB = 143360;
constexpr int LDS_BARST = 143360 + 1024;
constexpr size_t WS_BAR = 0;

struct Args { const float* in[N_IN]; float* out; unsigned char* ws; };

__device__ __forceinline__ void sincos_turns(float t, float* sn, float* cs) { *sn = __builtin_amdgcn_sinf(t); *cs = __builtin_amdgcn_cosf(t); }
__device__ __forceinline__ float wave_sum(float v) {
#pragma unroll
    for (int o = 1; o < 64; o <<= 1) v += __shfl_xor(v, o);
    return v;
}

struct TItem { const float* W; f16* WT; int K, N, item, swz; };
__device__ __forceinline__ void titem_load(const TItem& d, f32x4 (&t)[8], int lane) {
    const int nblk = d.N / 32, kb = d.item / nblk, nb = d.item % nblk, k0 = 64 * kb, n0 = 32 * nb;
#pragma unroll
    for (int i = 0; i < 8; ++i) t[i] = *(const f32x4*)(d.W + (size_t)(k0 + 8 * i + (lane >> 3)) * d.N + n0 + 4 * (lane & 7));
}
__device__ __forceinline__ void titem_finish(const TItem& d, const f32x4 (&t)[8], LAS float* scr, int lane) {
    const int nblk = d.N / 32, kb = d.item / nblk, nb = d.item % nblk, k0 = 64 * kb, n0 = 32 * nb;
#pragma unroll
    for (int i = 0; i < 8; ++i) { LAS float* p = scr + (8 * i + (lane >> 3)) * 33 + 4 * (lane & 7); p[0] = t[i].x; p[1] = t[i].y; p[2] = t[i].z; p[3] = t[i].w; }
    asm volatile("s_waitcnt lgkmcnt(0)" ::: "memory");
    int r0 = n0;
    if (d.swz) { const int blk = n0 >> 7, within = n0 & 127; r0 = (blk < 22) ? (256 * blk + within) : (256 * (blk - 22) + 128 + within); }
    const int c = lane & 7;
#pragma unroll
    for (int j = 0; j < 4; ++j) { const int n = (lane >> 3) + 8 * j; const LAS float* s = scr + (8 * c) * 33 + n;
        u32x4 o; o.x = pk2h(s[0 * 33], s[1 * 33]); o.y = pk2h(s[2 * 33], s[3 * 33]); o.z = pk2h(s[4 * 33], s[5 * 33]); o.w = pk2h(s[6 * 33], s[7 * 33]);
        *(u32x4*)(d.WT + (size_t)(r0 + n) * d.K + k0 + 8 * c) = o; }
    asm volatile("s_waitcnt lgkmcnt(0)" ::: "memory");
}
constexpr int CVT_NITEMS = 2 * 16 * 176 + 2 * 44 * 32 + 16 * 200 + 8 * 32 + 2 * 4 * 32 + 16 * 32;
__device__ __forceinline__ TItem cvt_item(const KP& a, int l, f16* WB, int it) {
    constexpr int IT13 = 16 * 176, IT2 = 44 * 32, ITIN = 16 * 200, ITA = 8 * 32, ITC = 4 * 32;
    int r = it; TItem d;
    if (r < 2 * IT13) { const int s = r / IT13; d.W = a.in(I_W13) + (size_t)(l * 2 + s) * DMODEL * 2 * DFF; d.K = DMODEL; d.N = 2 * DFF; d.WT = WB + OFF_W13 + s * W13_E; d.swz = 1; d.item = r % IT13; return d; } r -= 2 * IT13;
    if (r < 2 * IT2) { const int s = r / IT2; d.W = a.in(I_W2) + (size_t)(l * 2 + s) * DFF * DMODEL; d.K = DFF; d.N = DMODEL; d.WT = WB + OFF_W2 + s * W2_E; d.swz = 0; d.item = r % IT2; return d; } r -= 2 * IT2;
    d.swz = 0; d.item = r;
    if (r < ITIN) { d.W = a.in(I_WIN) + (size_t)l * DMODEL * INW; d.K = DMODEL; d.N = INW; d.WT = WB + OFF_WIN; return d; } r -= ITIN; d.item = r;
    if (r < ITA) { d.W = a.in(I_WAO) + (size_t)l * 512 * 1024; d.K = 512; d.N = 1024; d.WT = WB + OFF_WA; return d; } r -= ITA; d.item = r;
    if (r < ITC) { d.W = a.in(I_WCO) + (size_t)l * 256 * 1024; d.K = 256; d.N = 1024; d.WT = WB + OFF_WC; return d; } r -= ITC; d.item = r;
    if (r < ITC) { d.W = a.in(I_WSO) + (size_t)l * 256 * 1024; d.K = 256; d.N = 1024; d.WT = WB + OFF_WS; return d; } r -= ITC; d.item = r;
    d.W = a.in(I_WO) + (size_t)l * 1024 * 1024; d.K = 1024; d.N = 1024; d.WT = WB + OFF_WO; return d;
}
__device__ __forceinline__ void convert_weights(const KP& a, int l, f16* WB, LAS unsigned char* lds, int widx, int nw, int it_lo, int it_hi, int ftid, int fnt, int wave, int lane) {
    LAS float* scr = (LAS float*)(lds + wave * 16384);
    {
        int it = it_lo + widx; TItem d0; f32x4 tA[8];
        if (it < it_hi) { d0 = cvt_item(a, l, WB, it); titem_load(d0, tA, lane); }
        for (; it < it_hi; it += nw) {
            const int itn = it + nw; TItem d1 = d0; f32x4 tB[8];
            if (itn < it_hi) { d1 = cvt_item(a, l, WB, itn); titem_load(d1, tB, lane); }
            titem_finish(d0, tA, scr, lane);
            d0 = d1;
#pragma unroll
            for (int i = 0; i < 8; ++i) tA[i] = tB[i];
        }
    }
    const LAS float* ctab = (const LAS float*)(lds + LDS_TAB); const LAS float* stab = ctab + 64;
    const float* wf = a.in(I_WFN) + (size_t)l * 256 * 1024;
    if (fnt > 0)
    for (int idx = ftid; idx < 65536; idx += fnt) {
        const int o = idx & 1023, rest = idx >> 10, j8 = rest & 7, g = (rest >> 3) & 3, part = rest >> 5;
        float acc[8];
#pragma unroll
        for (int i = 0; i < 8; ++i) acc[i] = 0.f;
        const LAS float* tab = part ? stab : ctab;
#pragma unroll 1
        for (int m0 = 0; m0 < 64; m0 += 16) { float wv[16];
#pragma unroll
            for (int mm = 0; mm < 16; ++mm) wv[mm] = wf[(size_t)(g * 64 + m0 + mm) * 1024 + o];
#pragma unroll
            for (int mm = 0; mm < 16; ++mm)
#pragma unroll
                for (int i = 0; i < 8; ++i) acc[i] += tab[((m0 + mm) * (j8 * 8 + i)) & 63] * wv[mm]; }
        u32x4 w; w.x = pk2h(acc[0] * 0.125f, acc[1] * 0.125f); w.y = pk2h(acc[2] * 0.125f, acc[3] * 0.125f); w.z = pk2h(acc[4] * 0.125f, acc[5] * 0.125f); w.w = pk2h(acc[6] * 0.125f, acc[7] * 0.125f);
        *(u32x4*)(WB + OFF_WF + (size_t)o * 512 + part * 256 + g * 64 + j8 * 8) = w;
    }
}
__device__ __forceinline__ void phase0(const KP& a, LAS unsigned char* lds, int gw, int NGW, int wave, int lane) {
    const int tid = fresh_tid();
    {
        LAS float* sl = (LAS float*)lds; LAS float* sc = sl + 1024; LAS float* red = sl + 2048;
        float* MOD = (float*)(a.ws() + WS_MOD);
        bool have = false;
        for (int u = blockIdx.x; u < DEPTH * 36; u += gridDim.x) {
            if (!have) { for (int k = tid; k < 1024; k += NTHR) { sl[k] = silu_f(a.in(I_C)[k]); sc[k] = silu_f(a.in(I_CCTX)[k]); } have = true; __syncthreads(); }
            const int l = u / 36, strip = u % 36;
            const float* wp = a.in(I_WADA) + ((size_t)l * 1024 + wave * 128) * 9216 + strip * 256 + 4 * lane;
            f32x4 a0 = {0.f, 0.f, 0.f, 0.f}, a1 = {0.f, 0.f, 0.f, 0.f};
#pragma unroll 8
            for (int k = 0; k < 128; ++k) { const f32x4 wv = *(const f32x4*)(wp + (size_t)k * 9216); a0 += sl[wave * 128 + k] * wv; a1 += sc[wave * 128 + k] * wv; }
            *(LAS f32x4*)(red + (wave * 2 + 0) * 256 + 4 * lane) = a0; *(LAS f32x4*)(red + (wave * 2 + 1) * 256 + 4 * lane) = a1;
            __syncthreads();
            { const int s = tid >> 8, c = tid & 255; float v = a.in(I_BADA)[l * 9216 + strip * 256 + c];
#pragma unroll
              for (int w = 0; w < 8; ++w) v += red[(w * 2 + s) * 256 + c];
              MOD[(size_t)(l * 2 + s) * 9216 + strip * 256 + c] = v; }
            __syncthreads();
        }
        __syncthreads();
    }
    const int gt = blockIdx.x * NTHR + tid, GT = gridDim.x * NTHR;
    { f16* D1 = (f16*)(a.ws() + WS_D1); f16* D2 = (f16*)(a.ws() + WS_D2); f16* DC = (f16*)(a.ws() + WS_DC);
      const float s128 = 0.08838834764831845f;
      for (int i = gt; i < 32768 + 65536 + 131072; i += GT) {
          float sn, cs;
          if (i < 32768) { const int r = i >> 7, n1 = i & 127, k1 = r & 127; sincos_turns((float)((k1 * n1) & 127) * (1.0f / 128.0f), &sn, &cs); D1[i] = (f16)((r < 128 ? cs : -sn) * s128); }
          else if (i < 32768 + 65536) { const int ii = i - 32768, r = ii >> 8, kk = ii & 255, k2 = r & 127, n2 = kk >> 1, p = kk & 1; sincos_turns((float)((k2 * n2) & 127) * (1.0f / 128.0f), &sn, &cs);
              const float v = (r < 128) ? (p ? sn : cs) : (p ? cs : -sn); D2[ii] = (f16)(v * s128); }
          else { const int ii = i - 32768 - 65536, h = ii >> 16, r = (ii >> 8) & 255, n = ii & 255, rt = r >> 7, k = 128 * h + (r & 127); sincos_turns((float)((k * n) & 255) * (1.0f / 256.0f), &sn, &cs);
              DC[ii] = (f16)((rt ? -sn : cs) * 0.0625f); }
      } }
    convert_weights(a, 0, (f16*)(a.ws() + WS_W), lds, gw, NGW, 0, CVT_NITEMS, gt, GT, wave, lane);
}

template <bool FROM_INPUT> __device__ __forceinline__ void norm_phase(const KP& a, int l, int slot, int nslab, int gw, int NGW, int lane) {
    f16* X = (f16*)(a.ws() + WS_X); f16* H = (f16*)(a.ws() + WS_H); const float* PART = (const float*)(a.ws() + WS_PART);
    const float* g = a.in(I_NORMG) + (size_t)(l * 3 + slot) * 1024; const float* MOD = (const float*)(a.ws() + WS_MOD);
    const float* xin = a.in(I_X); const float* cin = a.in(I_CTX);
    for (int r0 = gw; r0 < T; r0 += 2 * NGW) {
        f32x4 v[2][4];
#pragma unroll
        for (int q = 0; q < 2; ++q) { const int r = r0 + q * NGW; if (r < T && !(nslab < 0 && r < CTX)) {
            if (FROM_INPUT) { const f32x4* xr = (const f32x4*)(r < CTX ? cin + (size_t)r * 1024 : xin + (size_t)(r - CTX) * 1024) + lane;
#pragma unroll
                for (int j = 0; j < 4; ++j) v[q][j] = xr[64 * j]; }
            else { const h16x4* xr = (const h16x4*)(X + (size_t)r * 1024) + lane;
#pragma unroll
                for (int j = 0; j < 4; ++j) { const h16x4 hv = xr[64 * j]; v[q][j] = (f32x4){(float)hv[0], (float)hv[1], (float)hv[2], (float)hv[3]}; } } } }
#pragma unroll
        for (int q = 0; q < 2; ++q) { const int r = r0 + q * NGW; if (r < T && !(nslab < 0 && r < CTX)) {
            const float* md = MOD + (size_t)(l * 2 + (r < CTX ? 1 : 0)) * 9216; const float* shift = md + (3 * slot) * 1024; const float* scale = md + (3 * slot + 1) * 1024;
            if (FROM_INPUT) { u32x2* xw = (u32x2*)(X + (size_t)r * 1024) + lane;
#pragma unroll
                for (int j = 0; j < 4; ++j) { u32x2 w; w.x = pk2h(v[q][j].x, v[q][j].y); w.y = pk2h(v[q][j].z, v[q][j].w); xw[64 * j] = w; } }
            if (r < CTX && nslab > 0) {
                for (int s0 = 0; s0 < nslab; s0 += 4) { f32x4 pv[4][4];
#pragma unroll
                    for (int k = 0; k < 4; ++k) { if (s0 + k < nslab) { const f32x4* pr = (const f32x4*)(PART + ((size_t)(s0 + k) * 256 + r) * 1024) + lane;
#pragma unroll
                        for (int j = 0; j < 4; ++j) pv[k][j] = pr[64 * j]; } }
#pragma unroll
                    for (int k = 0; k < 4; ++k) { if (s0 + k < nslab) {
#pragma unroll
                        for (int j = 0; j < 4; ++j) v[q][j] += pv[k][j]; } } }
                u32x2* xw = (u32x2*)(X + (size_t)r * 1024) + lane;
#pragma unroll
                for (int j = 0; j < 4; ++j) { u32x2 w; w.x = pk2h(v[q][j].x, v[q][j].y); w.y = pk2h(v[q][j].z, v[q][j].w); xw[64 * j] = w; } }
            float ss = 0.f;
#pragma unroll
            for (int j = 0; j < 4; ++j) ss += (v[q][j].x * v[q][j].x + v[q][j].y * v[q][j].y) + (v[q][j].z * v[q][j].z + v[q][j].w * v[q][j].w);
            const float rstd = 1.0f / sqrtf(wave_sum(ss) * (1.0f / 1024.0f) + EPS);
            u32x2* o8 = (u32x2*)(H + (size_t)r * 1024) + lane;
#pragma unroll
            for (int j = 0; j < 4; ++j) { const int c = 4 * lane + 256 * j; const f32x4 gg = *(const f32x4*)(g + c), sc = *(const f32x4*)(scale + c), sh = *(const f32x4*)(shift + c);
                const f32x4 o = (v[q][j] * rstd) * gg * (sc + 1.0f) + sh; u32x2 w; w.x = pk2h(o.x, o.y); w.y = pk2h(o.z, o.w); o8[64 * j] = w; } } }
    }
}
__device__ __forceinline__ void final_norm(const KP& a, int gw, int NGW, int lane) {
    const f16* X = (const f16*)(a.ws() + WS_X) + (size_t)CTX * 1024; const float* g = a.in(I_FNG); float* out = a.out();
    for (int r0 = gw; r0 < SEQ; r0 += 2 * NGW) {
        f32x4 v[2][4];
#pragma unroll
        for (int q = 0; q < 2; ++q) { const int r = r0 + q * NGW; if (r < SEQ) { const h16x4* xr = (const h16x4*)(X + (size_t)r * 1024) + lane;
#pragma unroll
            for (int j = 0; j < 4; ++j) { const h16x4 hv = xr[64 * j]; v[q][j] = (f32x4){(float)hv[0], (float)hv[1], (float)hv[2], (float)hv[3]}; } } }
#pragma unroll
        for (int q = 0; q < 2; ++q) { const int r = r0 + q * NGW; if (r < SEQ) { float ss = 0.f;
#pragma unroll
            for (int j = 0; j < 4; ++j) ss += (v[q][j].x * v[q][j].x + v[q][j].y * v[q][j].y) + (v[q][j].z * v[q][j].z + v[q][j].w * v[q][j].w);
            const float rstd = 1.0f / sqrtf(wave_sum(ss) * (1.0f / 1024.0f) + EPS);
            f32x4* o = (f32x4*)(out + (size_t)r * 1024) + lane;
#pragma unroll
            for (int j = 0; j < 4; ++j) o[64 * j] = (v[q][j] * rstd) * *(const f32x4*)(g + 4 * lane + 256 * j); } }
    }
}

__device__ __forceinline__ void qkv_prep(const KP& a, int l, int gw, int NGW, int lane) {
    const f16* WINB = (const f16*)(a.ws() + WS_WINB); f16* QB = (f16*)(a.ws() + WS_QB); f16* KB = (f16*)(a.ws() + WS_KB); f16* VB = (f16*)(a.ws() + WS_VB);
    const int j = lane & 7;
    float gq[8], gk[8], invf[8];
#pragma unroll
    for (int i = 0; i < 8; ++i) { gq[i] = a.in(I_QNG)[l * 64 + j * 8 + i]; gk[i] = a.in(I_KNG)[l * 64 + j * 8 + i];
        invf[i] = exp2f(-(float)(8 * (j & 1) + i) * (13.287712379549449f / 16.0f)); }
    const bool p1 = (j >> 1) & 1;
#pragma unroll 2
    for (int r = gw; r < T; r += NGW) {
        const f16* wrow = WINB + (size_t)r * WP;
        float cs[8], sn[8];
        const bool lat = r >= CTX;
        if (lat) { const int n = r - CTX; const float pos = (float)((j >> 2) ? (n & 63) : (n >> 6));
#pragma unroll
            for (int i = 0; i < 8; ++i) { const float ang = pos * invf[i]; sincos_turns(ang * 0.15915494309189535f, &sn[i], &cs[i]); } }
        else {
#pragma unroll
            for (int i = 0; i < 8; ++i) { cs[i] = 1.f; sn[i] = 0.f; } }
        { const h16x8 qv = *(const h16x8*)(wrow + C_Q + lane * 8); float x[8]; float ss = 0.f;
#pragma unroll
          for (int i = 0; i < 8; ++i) { x[i] = (float)qv[i]; ss += x[i] * x[i]; }
          ss += __shfl_xor(ss, 1); ss += __shfl_xor(ss, 2); ss += __shfl_xor(ss, 4);
          const float rs = 1.0f / sqrtf(ss * (1.0f / 64.0f) + EPS);
          float y[8];
#pragma unroll
          for (int i = 0; i < 8; ++i) { x[i] = x[i] * rs * gq[i]; }
#pragma unroll
          for (int i = 0; i < 8; ++i) { const float xp = __shfl_xor(x[i], 2); y[i] = p1 ? (xp * sn[i] + x[i] * cs[i]) : (x[i] * cs[i] - xp * sn[i]); y[i] *= QSCALE; }
          u32x4 w; w.x = pk2h(y[0], y[1]); w.y = pk2h(y[2], y[3]); w.z = pk2h(y[4], y[5]); w.w = pk2h(y[6], y[7]);
          *(u32x4*)(QB + (size_t)r * 512 + lane * 8) = w; }
        { const int lk = lane & 15; const h16x8 kv = *(const h16x8*)(wrow + C_K + lk * 8); float x[8]; float ss = 0.f;
#pragma unroll
          for (int i = 0; i < 8; ++i) { x[i] = (float)kv[i]; ss += x[i] * x[i]; }
          ss += __shfl_xor(ss, 1); ss += __shfl_xor(ss, 2); ss += __shfl_xor(ss, 4);
          const float rs = 1.0f / sqrtf(ss * (1.0f / 64.0f) + EPS);
          float y[8];
#pragma unroll
          for (int i = 0; i < 8; ++i) { x[i] = x[i] * rs * gk[i]; }
#pragma unroll
          for (int i = 0; i < 8; ++i) { const float xp = __shfl_xor(x[i], 2); y[i] = p1 ? (xp * sn[i] + x[i] * cs[i]) : (x[i] * cs[i] - xp * sn[i]); }
          u32x4 w; w.x = pk2h(y[0], y[1]); w.y = pk2h(y[2], y[3]); w.z = pk2h(y[4], y[5]); w.w = pk2h(y[6], y[7]);
          if (lane < 16) *(u32x4*)(KB + (size_t)r * 128 + lane * 8) = w;
          else if (lane < 32) *(u32x4*)(VB + (size_t)r * 128 + (lane - 16) * 8) = *(const u32x4*)(wrow + C_V + (lane - 16) * 8); }
    }
}
__device__ __forceinline__ void conv_unit(const KP& a, int l, int u, LAS unsigned char* lds, int wave, int lane) {
    const int tid = fresh_tid();
    const f16* WINB = (const f16*)(a.ws() + WS_WINB); f16* CV = (f16*)(a.ws() + WS_CV); f16* SCB = (f16*)(a.ws() + WS_SCB);
    const int seq0 = (u < 4) ? 0 : CTX, seq1 = (u < 4) ? CTX : T, r0 = (u < 4) ? 64 * u : CTX + 64 * (u - 4);
    LAS f16* tile = (LAS f16*)lds;
    LAS float* co = (LAS float*)(lds + 49152);
    { h16x8 a1[6], a2[6];
#pragma unroll
      for (int it = 0; it < 6; ++it) { const int idx = tid + it * NTHR, lr = idx >> 5, c8 = idx & 31, r = r0 - 15 + lr;
          if (idx < 94 * 32 && r >= seq0 && r < seq1) { a1[it] = *(const h16x8*)(WINB + (size_t)r * WP + C_CG + c8 * 8); a2[it] = *(const h16x8*)(WINB + (size_t)r * WP + C_CG + 256 + c8 * 8); } }
#pragma unroll
      for (int it = 0; it < 6; ++it) { const int idx = tid + it * NTHR, lr = idx >> 5, c8 = idx & 31, r = r0 - 15 + lr;
          if (idx < 94 * 32) { h16x8 o;
#pragma unroll
              for (int i = 0; i < 8; ++i) o[i] = (f16)0.f;
              if (r >= seq0 && r < seq1) {
#pragma unroll
                  for (int i = 0; i < 8; ++i) o[i] = (f16)((float)a1[it][i] * sigm_f((float)a2[it][i])); }
              *(LAS h16x8*)(tile + lr * 256 + c8 * 8) = o; } } }
    __syncthreads();
    { const int c = tid & 255, half = tid >> 8; float w[31];
#pragma unroll
      for (int t = 0; t < 31; ++t) w[t] = a.in(I_CDW)[(size_t)(l * 31 + t) * 256 + c];
      const float bias = a.in(I_CDB)[l * 256 + c];
      float xin[62];
#pragma unroll
      for (int i = 0; i < 62; ++i) xin[i] = (float)tile[(half * 32 + i) * 256 + c];
#pragma unroll
      for (int o = 0; o < 32; ++o) { float acc = bias;
#pragma unroll
          for (int t = 0; t < 31; ++t) acc += xin[o + t] * w[t];
          co[(half * 32 + o) * 256 + c] = acc; } }
    __syncthreads();
    { const f32x4 lg = *(const f32x4*)(a.in(I_CLG) + l * 256 + 4 * lane), lb = *(const f32x4*)(a.in(I_CLB) + l * 256 + 4 * lane);
#pragma unroll 1
      for (int tt = 0; tt < 8; ++tt) { const int tok = wave * 8 + tt; const f32x4 v = *(const LAS f32x4*)(co + tok * 256 + 4 * lane);
          const float mean = wave_sum((v.x + v.y) + (v.z + v.w)) * (1.0f / 256.0f); const f32x4 d = v - mean;
          const float var = wave_sum((d.x * d.x + d.y * d.y) + (d.z * d.z + d.w * d.w)) * (1.0f / 256.0f); const float rstd = 1.0f / sqrtf(var + EPS);
          f32x4 y = d * rstd * lg + lb; y.x = silu_f(y.x); y.y = silu_f(y.y); y.z = silu_f(y.z); y.w = silu_f(y.w);
          u32x2 w; w.x = pk2h(y.x, y.y); w.y = pk2h(y.z, y.w); *(u32x2*)(CV + (size_t)(r0 + tok) * 256 + 4 * lane) = w; } }
    for (int idx = tid; idx < 64 * 32; idx += NTHR) { const int lr = idx >> 5, c8 = idx & 31, r = r0 + lr; float acc[8];
#pragma unroll
        for (int i = 0; i < 8; ++i) acc[i] = 0.f;
#pragma unroll
        for (int t = 0; t < 3; ++t) { const int rr = r + t - 1; if (rr >= seq0 && rr < seq1) {
            const h16x8 gc = *(const h16x8*)(WINB + (size_t)rr * WP + C_SC + 256 + c8 * 8), hh = *(const h16x8*)(WINB + (size_t)rr * WP + C_SC + 512 + c8 * 8);
            const float* wp = a.in(I_SCW) + (size_t)(l * 3 + t) * 256 + c8 * 8;
#pragma unroll
            for (int i = 0; i < 8; ++i) acc[i] += (float)gc[i] * (float)hh[i] * wp[i]; } }
        const h16x8 gb = *(const h16x8*)(WINB + (size_t)r * WP + C_SC + c8 * 8);
        u32x4 w; w.x = pk2h((float)gb[0] * acc[0], (float)gb[1] * acc[1]); w.y = pk2h((float)gb[2] * acc[2], (float)gb[3] * acc[3]);
        w.z = pk2h((float)gb[4] * acc[4], (float)gb[5] * acc[5]); w.w = pk2h((float)gb[6] * acc[6], (float)gb[7] * acc[7]);
        *(u32x4*)(SCB + (size_t)r * 256 + c8 * 8) = w; }
    __syncthreads();
}
template <int K, int NCT, class Epi>
__device__ __forceinline__ void dft_unit(LAS unsigned char* lds, const f16* gsrc, size_t rstride, const f16* Dm, int ch0, const Epi& E) {
    constexpr int LPB = 516;
    const int tid = fresh_tid(), lane = tid & 63, wave = tid >> 6, fr = lane & 15, fq = lane >> 4;
    { constexpr int NIT = K * 16 * NCT / NTHR; u32x4 sv[NIT];
#pragma unroll
      for (int it = 0; it < NIT; ++it) { const int i = tid + it * NTHR, row = i / (16 * NCT), pc = i % (16 * NCT); sv[it] = *(const u32x4*)(gsrc + (size_t)row * rstride + ch0 + pc * 8); }
#pragma unroll
      for (int it = 0; it < NIT; ++it) { const int i = tid + it * NTHR, row = i / (16 * NCT), pc = i % (16 * NCT);
          LAS unsigned* d = (LAS unsigned*)(lds + row * LPB + pc * 16); d[0] = sv[it].x; d[1] = sv[it].y; d[2] = sv[it].z; d[3] = sv[it].w; } }
    __syncthreads();
    const int cbase = wave * 16 * NCT;
    h16x8 df[NCT][K / 32];
#pragma unroll
    for (int ct = 0; ct < NCT; ++ct)
#pragma unroll
        for (int ks = 0; ks < K / 32; ++ks)
#pragma unroll
            for (int e = 0; e < 8; ++e) df[ct][ks][e] = *(const LAS f16*)(lds + (ks * 32 + fq * 8 + e) * LPB + (cbase + ct * 16 + fr) * 2);
    h16x8 dm[2][2][K / 32];
#define DFT_LOAD_DM(buf, jj) do { _Pragma("unroll") for (int rt = 0; rt < 2; ++rt) _Pragma("unroll") for (int ks = 0; ks < K / 32; ++ks) \
        dm[buf][rt][ks] = *(const h16x8*)(Dm + (size_t)(rt * 128 + (jj) * 16 + fr) * K + ks * 32 + fq * 8); } while (0)
    DFT_LOAD_DM(0, 0);
#pragma unroll
    for (int j = 0; j < 8; ++j) {
        if (j + 1 < 8) DFT_LOAD_DM((j + 1) & 1, j + 1);
        f32x4 acc[2][NCT];
#pragma unroll
        for (int rt = 0; rt < 2; ++rt)
#pragma unroll
            for (int ct = 0; ct < NCT; ++ct) acc[rt][ct] = (f32x4){0.f, 0.f, 0.f, 0.f};
#pragma unroll
        for (int rt = 0; rt < 2; ++rt)
#pragma unroll
            for (int ks = 0; ks < K / 32; ++ks)
#pragma unroll
                for (int ct = 0; ct < NCT; ++ct) acc[rt][ct] = __builtin_amdgcn_mfma_f32_16x16x32_f16(df[ct][ks], dm[j & 1][rt][ks], acc[rt][ct], 0, 0, 0);
#pragma unroll
        for (int ct = 0; ct < NCT; ++ct) E(j * 16 + fr, ch0 + cbase + ct * 16 + 4 * fq, acc[0][ct], acc[1][ct]);
    }
#undef DFT_LOAD_DM
    __syncthreads();
}
__device__ __forceinline__ void st4h(f16* p, f32x4 v) { u32x2 w; w.x = pk2h(v.x, v.y); w.y = pk2h(v.z, v.w); *(u32x2*)p = w; }
struct EpiB1 { f16* AP; int n2;
    __device__ __forceinline__ void operator()(int k1, int c, f32x4 re, f32x4 im) const {
        float sn, cs; sincos_turns((float)((k1 * n2) & 16383) * (1.0f / 16384.0f), &sn, &cs);
        const f32x4 ar = re * cs + im * sn, ai = im * cs - re * sn;
        f16* p = AP + ((size_t)(k1 * 128 + n2) * 2) * 256 + c; st4h(p, ar); st4h(p + 256, ai); } };
struct EpiB2 { f16* FO; int k1;
    __device__ __forceinline__ void operator()(int k2, int c, f32x4 re, f32x4 im) const {
        f16* p = FO + (size_t)(CTX + k1 + 128 * k2) * 512 + c; st4h(p, re); st4h(p + 256, im); } };
struct EpiDC { f16* FO; int h;
    __device__ __forceinline__ void operator()(int kk, int c, f32x4 re, f32x4 im) const {
        f16* p = FO + (size_t)(128 * h + kk) * 512 + c; st4h(p, re); st4h(p + 256, im); } };

template <class Epi> __device__ __forceinline__ void run_gemm(LAS unsigned char* lds, const f16* A, const f16* Bt, int M, int N, int K, const Epi& E) {
    pg8::Gemm g{(const pg8::bf16_t*)A, (const pg8::bf16_t*)Bt, M, N, K}; pg8::StaticOrder S; S.init(M, N, (int)gridDim.x, (int)blockIdx.x); S.nt0 = K / pg8::BK;
    pg8::gemm_phase<Epi, pg8::StaticOrder, true, true>(lds, g, S, E);
}

template <class Epi> __device__ __forceinline__ void run_gemm_ctx(LAS unsigned char* lds, const f16* A, const f16* Bt, int K, int S, int coff, const Epi& E) {
    pg8::Gemm g{(const pg8::bf16_t*)A, (const pg8::bf16_t*)Bt, T, DMODEL, K}; pg8::CtxSplitOrder O; O.init(K, S, (int)gridDim.x, (int)blockIdx.x, coff);
    pg8::gemm_phase<Epi, pg8::CtxSplitOrder, true, true>(lds, g, O, E);
}
#ifndef REP_MIX
#define REP_MIX 1
#endif
#ifndef REP_GEMM
#define REP_GEMM 1
#endif
#ifndef REP_LIGHT
#define REP_LIGHT 1
#endif
#ifndef REP_P0
#define REP_P0 1
#endif
#ifndef REP_QKV
#define REP_QKV 1
#endif
#ifndef REP_BAR
#define REP_BAR 1
#endif
#ifdef AMP_CLS
#define TMARK(cls) do { const unsigned now_ = (unsigned)__builtin_amdgcn_s_memrealtime(); const unsigned d_ = now_ - t_last; \
    if ((cls) == AMP_CLS && blockIdx.x == 0) { const unsigned until_ = now_ + AMP_MUL * d_; while ((int)((unsigned)__builtin_amdgcn_s_memrealtime() - until_) < 0) __builtin_amdgcn_s_sleep(8); } \
    t_last = (unsigned)__builtin_amdgcn_s_memrealtime(); } while (0)
#elif defined(PROBE_T)
#define TMARK(cls) do { const unsigned now_ = (unsigned)__builtin_amdgcn_s_memrealtime(); const unsigned d_ = now_ - t_last; t_last = now_; if ((cls) == PROBE_A) tA += d_; if ((cls) == PROBE_B) tB += d_; } while (0)
#else
#define TMARK(cls) do {} while (0)
#endif
#define TAIL_CONVERT(nwg, lo, hi, with_fnet) do { if (l + 1 < DEPTH) { const int rounds_ = ((nwg) + G - 1) / G, busy_ = (nwg) - (rounds_ - 1) * G, idle_ = G - busy_; \
    if (idle_ == 0) convert_weights(a, l + 1, (f16*)(ws + wbnext), lds, gw, NGW, (lo), (hi), (with_fnet) ? gw * 64 + lane : 0, (with_fnet) ? NGW * 64 : 0, wave, lane); \
    else if (bx >= busy_) { const int widx_ = (bx - busy_) * NWAVES + wave, nw_ = idle_ * NWAVES; \
        convert_weights(a, l + 1, (f16*)(ws + wbnext), lds, widx_, nw_, (lo), (hi), (with_fnet) ? widx_ * 64 + lane : 0, (with_fnet) ? nw_ * 64 : 0, wave, lane); } } } while (0)
#define FRESH() const KP a = fresh_kp(); const int tid = fresh_tid(); const int lane = tid & 63; const int wave = __builtin_amdgcn_readfirstlane(tid >> 6); \
    const int gw = bx * NWAVES + wave; unsigned char* const ws = a.ws(); (void)lane; (void)gw; (void)ws
#define XBAR() do { for (int rb_ = 0; rb_ < REP_BAR; ++rb_) xcd_barrier(xbar); } while (0)
__global__ void __launch_bounds__(NTHR, 2) fwd_megakernel(Args a_unused) {
    extern __shared__ __attribute__((aligned(16))) unsigned char lds_raw[];
    cg::grid_group grid = cg::this_grid();
    LAS unsigned char* lds = (LAS unsigned char*)lds_raw;
    const int G = gridDim.x, bx = blockIdx.x;
    const int vcu = (G % 8 == 0) ? (bx % 8) * (G / 8) + bx / 8 : bx;
    const int NGW = G * NWAVES;
#ifdef AMP_CLS
    unsigned t_last = (unsigned)__builtin_amdgcn_s_memrealtime();
#elif defined(PROBE_T)
    unsigned tA = 0, tB = 0, t_last = (unsigned)__builtin_amdgcn_s_memrealtime();
#endif
    {
        FRESH();
        if (tid < 64) { float sn, cs; sincos_turns((float)tid * (1.0f / 64.0f), &sn, &cs); LAS float* ctab = (LAS float*)(lds + LDS_TAB); ctab[tid] = cs; ctab[64 + tid] = sn; }
        if (tid < 2) ((LAS unsigned*)(lds + LDS_BARST))[tid] = 0u;
        if (bx == 0) for (int i = tid; i < XCD_BAR_WORDS; i += NTHR) ((unsigned*)(ws + WS_BAR))[i] = 0u;
        __syncthreads();
#ifndef NO_P0
        for (int rep = 0; rep < REP_P0; ++rep) phase0(a, lds, gw, NGW, wave, lane);
#endif
    }
    grid.sync(); TMARK(0);
    XcdBarrier xbar;
    { FRESH(); xbar = xcd_barrier_post((unsigned*)(ws + WS_BAR), (volatile LAS unsigned*)(lds + LDS_BARST)); }


#pragma unroll 1
    for (int l = 0; l < DEPTH; ++l) {
        const bool lastl = (l == DEPTH - 1);
        const size_t wboff = (l & 1) ? WS_M32 : WS_W, wbnext = (l & 1) ? WS_W : WS_M32;
#pragma unroll 1
        for (int half = 0; half < 2; ++half) {
            const int slot = 2 * half;
            {
                FRESH();
                if (l == 0 && half == 0) norm_phase<true>(a, 0, 0, 0, gw, NGW, lane);
                else norm_phase<false>(a, l, slot, (half == 1) ? (lastl ? -1 : 4) : 11, gw, NGW, lane);
            }
            XBAR(); TMARK(1);
#ifndef NO_G1
            {
                FRESH();
#pragma unroll 1
                for (int rep = 0; rep < REP_GEMM; ++rep) {
                pg8::EpiSwiGLU E{(pg8::bf16_t*)(ws + WS_WINB), DFF};
                run_gemm(lds, (const f16*)(ws + WS_H), (const f16*)(ws + wboff) + OFF_W13 + half * W13_E, T, 2 * DFF, DMODEL, E); }
                if (half == 0) TAIL_CONVERT(65 * 22, 0, 3850, false); else TAIL_CONVERT(65 * 22, 8800, CVT_NITEMS, false);
            }
#endif
            XBAR(); TMARK(2);
#ifndef NO_G2
            {
                FRESH();
                const float* MOD = (const float*)(ws + WS_MOD);
#pragma unroll 1
                for (int rep = 0; rep < REP_GEMM; ++rep) {
                pg8::EpiResidual E{(pg8::bf16_t*)(ws + WS_X), MOD + (size_t)(l * 2 + 0) * 9216 + (3 * slot + 2) * 1024, MOD + (size_t)(l * 2 + 1) * 9216 + (3 * slot + 2) * 1024, (float*)(ws + WS_PART), rep ? 0.0f : 0.5f};
                run_gemm_ctx(lds, (const f16*)(ws + WS_WINB), (const f16*)(ws + wboff) + OFF_W2 + half * W2_E, DFF, 11, (lastl && half == 1) ? (1 << 20) : 0, E); }
            }
#endif
            XBAR(); TMARK(3);
            if (half == 1) break;
            {
                FRESH();
                norm_phase<false>(a, l, 1, 11, gw, NGW, lane);
            }
            XBAR(); TMARK(4);
#ifndef NO_G3
            {
                FRESH();
#pragma unroll 1
                for (int rep = 0; rep < REP_GEMM; ++rep) {
                pg8::EpiStoreF16 E{(pg8::bf16_t*)(ws + WS_WINB), WP, (unsigned char*)(ws + WS_G8), a.in(I_BGATE) + (size_t)l * 4096};
                run_gemm(lds, (const f16*)(ws + WS_H), (const f16*)(ws + wboff) + OFF_WIN, T, INW, DMODEL, E); }
                TAIL_CONVERT(65 * 25, 3850, 8800, true);
            }
#endif
            XBAR(); TMARK(5);
#pragma unroll 1
            for (int rep = 0; rep < REP_LIGHT; ++rep)
#pragma unroll 1
            for (int u = bx; u < 256 + 128 + 4 + 4; u += G) {
                FRESH();
                const f16* WINB = (const f16*)(ws + WS_WINB);
#ifndef NO_CONV
                if (u < 256) conv_unit(a, l, u + 4, lds, wave, lane); else if (u >= 388) conv_unit(a, l, u - 388, lds, wave, lane); else
#endif
#ifndef NO_DFT
                if (u < 384) { const int n2 = u - 256; EpiB1 E{(f16*)(ws + WS_AP), n2}; dft_unit<128, 2>(lds, WINB + (size_t)(CTX + n2) * WP + C_F, (size_t)128 * WP, (const f16*)(ws + WS_D1), 0, E); }
                else if (u < 388) { const int h = (u - 384) >> 1, chh = (u - 384) & 1; EpiDC E{(f16*)(ws + WS_FO), h}; dft_unit<256, 1>(lds, WINB + C_F, (size_t)WP, (const f16*)(ws + WS_DC) + (size_t)h * 65536, 128 * chh, E); }
#endif
                {}
            }
#ifndef NO_QKV
            {
                FRESH();
                for (int rep = 0; rep < REP_QKV; ++rep) qkv_prep(a, l, gw, NGW, lane);
            }
#endif
            XBAR(); TMARK(6);
#pragma unroll 1
            for (int rep = 0; rep < REP_MIX; ++rep)
#pragma unroll 1
            for (int idx = vcu; idx < 512 + 8 + 256; idx += G) {
                FRESH();
                const attn_body::bf16* QB = (const attn_body::bf16*)(ws + WS_QB); const attn_body::bf16* KB = (const attn_body::bf16*)(ws + WS_KB); const attn_body::bf16* VB = (const attn_body::bf16*)(ws + WS_VB);
                attn_body::bf16* AO = (attn_body::bf16*)(ws + WS_AO);
#ifndef NO_ATTN
                if (idx < 512) { const int v = idx & 255; attn_body::attn_unit<8>(v >> 5, 1 + 2 * (v & 31) + (idx >> 8), T / 64, QB, KB, VB, AO, (char*)lds_raw); }
                else if (idx < 520) { if (!lastl) attn_body::attn_unit<8>(idx - 512, 0, CTX / 64, QB, KB, VB, AO, (char*)lds_raw); }
                else
#endif
#ifndef NO_DFT2
                { const int k1 = (idx - 520) >> 1, chh = (idx - 520) & 1; EpiB2 E{(f16*)(ws + WS_FO), k1}; dft_unit<256, 1>(lds, (const f16*)(ws + WS_AP) + (size_t)k1 * 65536, (size_t)256, (const f16*)(ws + WS_D2), 128 * chh, E); }
#endif
                {}
            }
            XBAR(); TMARK(7);
#ifndef NO_G4
#pragma unroll 1
            for (int b = 0; b < 4 * REP_GEMM; ++b) {
                FRESH();
                const int b4 = b & 3; const f16* Ab = (const f16*)(ws + ((b4 == 0) ? WS_AO : (b4 == 1) ? WS_FO : (b4 == 2) ? WS_CV : WS_SCB));
                const f16* Wb = (const f16*)(ws + wboff) + ((b4 == 0) ? OFF_WA : (b4 == 1) ? OFF_WF : (b4 == 2) ? OFF_WC : OFF_WS);
                const int Kb = (b4 < 2) ? 512 : 256;
                pg8::EpiGate E{(const unsigned char*)(ws + WS_G8) + b4 * 1024, 4096, (float*)(ws + WS_M32), (pg8::bf16_t*)(ws + WS_MH), (float*)(ws + WS_PART) + (size_t)b4 * 256 * 1024, (b & 3) == 0, (b & 3) == 3};
                run_gemm_ctx(lds, Ab, Wb, Kb, 1, lastl ? (1 << 20) : 4 * b4, E);
            }
#endif
            XBAR(); TMARK(8);
            {
                FRESH();
                if (gw < CTX && !lastl) { const float* P = (const float*)(ws + WS_PART) + (size_t)gw * 1024; u32x2* o8 = (u32x2*)((f16*)(ws + WS_MH) + (size_t)gw * 1024) + lane;
#pragma unroll
                    for (int j = 0; j < 4; ++j) { f32x4 v = ((const f32x4*)P)[lane + 64 * j];
#pragma unroll
                        for (int s = 1; s < 4; ++s) v += ((const f32x4*)(P + (size_t)s * 256 * 1024))[lane + 64 * j];
                        u32x2 w; w.x = pk2h(v.x, v.y); w.y = pk2h(v.z, v.w); o8[64 * j] = w; } }
            }
            XBAR(); TMARK(11);
#ifndef NO_G5
            {
                FRESH();
                const float* MOD = (const float*)(ws + WS_MOD);
#pragma unroll 1
                for (int rep = 0; rep < REP_GEMM; ++rep) {
                pg8::EpiResidual E{(pg8::bf16_t*)(ws + WS_X), MOD + (size_t)(l * 2 + 0) * 9216 + 5 * 1024, MOD + (size_t)(l * 2 + 1) * 9216 + 5 * 1024, (float*)(ws + WS_PART), rep ? 0.0f : 1.0f};
                run_gemm_ctx(lds, (const f16*)(ws + WS_MH), (const f16*)(ws + wboff) + OFF_WO, DMODEL, 4, lastl ? (1 << 20) : 0, E); }
            }
#endif
            XBAR(); TMARK(9);
        }
    }
    {
        FRESH();
        final_norm(a, gw, NGW, lane);
    }
#ifdef PROBE_T
    XBAR(); TMARK(10);
    if (bx == 0) { FRESH(); float* o = a.out(); const float A = (float)tA * 0.01f, B = (float)tB * (0.01f / 16.0f);
        for (int i = tid; i <= 65536; i += NTHR) o[i] = (i == 0) ? A : B; }
#endif
}

extern "C" void kernel_launch(void* const* d_in, const int* in_sizes, int n_in, void* d_out, int out_size, void* d_ws, size_t ws_size, hipStream_t stream) {
    static int grid = 0;
    if (grid == 0) {
        if (n_in != N_IN || out_size != SEQ * DMODEL || ws_size < WS_END) { fprintf(stderr, "kernel_launch: unexpected shapes (n_in %d out %d ws %zu)\n", n_in, out_size, ws_size); grid = -1; return; }
        int dev = 0, cus = 0, per_cu = 0;
        if (hipGetDevice(&dev) != hipSuccess || hipDeviceGetAttribute(&cus, hipDeviceAttributeMultiprocessorCount, dev) != hipSuccess) { grid = -1; return; }
        if (hipFuncSetAttribute((const void*)fwd_megakernel, hipFuncAttributeMaxDynamicSharedMemorySize, LDS_BYTES) != hipSuccess) { fprintf(stderr, "kernel_launch: hipFuncSetAttribute failed\n"); grid = -1; return; }
        if (hipOccupancyMaxActiveBlocksPerMultiprocessor(&per_cu, (const void*)fwd_megakernel, NTHR, LDS_BYTES) != hipSuccess || per_cu < 1) { fprintf(stderr, "kernel_launch: occupancy query says %d\n", per_cu); per_cu = 1; }
        (void)hipGetLastError();
        grid = cus * per_cu;
    }
    if (grid < 0) return;
    Args a{};
    for (int i = 0; i < N_IN; ++i) a.in[i] = (const float*)d_in[i];
    a.out = (float*)d_out; a.ws = (unsigned char*)d_ws;
    void* args[] = {&a};
    hipError_t e = hipLaunchCooperativeKernel((const void*)fwd_megakernel, dim3(grid), dim3(NTHR), args, LDS_BYTES, stream);
    if (e != hipSuccess) fprintf(stderr, "kernel_launch: cooperative launch failed: %s (grid %d)\n", hipGetErrorString(e), grid);
}
```

```cpp
#include <hip/hip_runtime.h>
#include <hip/hip_cooperative_groups.h>
#include <cstdio>
#include <cstdint>
namespace cg = cooperative_groups;

__device__ __forceinline__ int fresh_tid() { int t = (int)threadIdx.x; asm volatile("" : "+v"(t)); return t; }
typedef const __attribute__((address_space(4))) unsigned char* kargp_t;
struct KP {
    kargp_t kp;
    __device__ __forceinline__ const float* in(int i) const { return *(const float* const __attribute__((address_space(4)))*)(kp + 8 * i); }
    __device__ __forceinline__ float* out() const { return *(float* const __attribute__((address_space(4)))*)(kp + 8 * 24); }
    __device__ __forceinline__ unsigned char* ws() const { return *(unsigned char* const __attribute__((address_space(4)))*)(kp + 8 * 25); }
};
__device__ __forceinline__ KP fresh_kp() { KP p; p.kp = (kargp_t)__builtin_amdgcn_kernarg_segment_ptr(); asm volatile("" : "+s"(p.kp)); return p; }
namespace pg8 {
#define PG8_LAS __attribute__((address_space(3)))
typedef unsigned short bf16_t;
typedef _Float16 bf16x8 __attribute__((ext_vector_type(8)));
typedef float f32x4 __attribute__((ext_vector_type(4)));
typedef unsigned u32x4 __attribute__((ext_vector_type(4)));
constexpr int BM = 256, BK = 64, HALF = 128, HTB = HALF * BK * 2  , STAGE_BYTES = 8 * HTB, NXCD = 8, WGM = 8;

__host__ __device__ __forceinline__ int lds_byte(int r, int c) { const int st = (r >> 4) * 2 + (c >> 5), rr = r & 15, cc = c & 31, ob = rr * 64 + cc * 2; return st * 1024 + (ob ^ (((ob >> 9) & 1) << 5)); }
__host__ __device__ __forceinline__ void stage_rc(int b, int& R, int& C) { const int st = b / 1024, sb = b % 1024, swz = sb ^ (((sb >> 9) & 1) << 5); R = (st >> 1) * 16 + swz / 64; C = (st & 1) * 32 + (swz % 64) / 2; }
__host__ __device__ __forceinline__ int perm32(int rho) { const int n = rho >> 4, i = rho & 15; return 8 * (i >> 2) + 4 * n + (i & 3); }

struct Unit { int pm, pn, koff, nt, ks; };
struct Gemm { const bf16_t* A; const bf16_t* Bt; int M, N, K; };

struct StaticOrder {
    int nM, nN, nwg, G, c, nt0;
    __host__ __device__ void init(int M, int N, int G_, int c_) { nM = M / BM; nN = N / BM; nwg = nM * nN; G = G_; c = c_; }
    __host__ __device__ bool next(int i, Unit& u) const {
        const long L = (long)i * G + c; if (L >= nwg) return false;
        int wgid = (int)L; { const int q = nwg / NXCD, r = nwg % NXCD, xcd = wgid % NXCD, off = wgid / NXCD; wgid = (xcd < r ? xcd * (q + 1) : r * (q + 1) + (xcd - r) * q) + off; }
        const int nig = WGM * nN, gid = wgid / nig, fm = gid * WGM, gsz = (nM - fm) < WGM ? (nM - fm) : WGM;
        u.pm = fm + ((wgid % nig) % gsz); u.pn = (wgid % nig) / gsz; u.koff = 0; u.nt = nt0; u.ks = 0; return true;
    }
    __device__ __forceinline__ void a_ready(const Unit&) const {}
    __device__ __forceinline__ void done(const Unit&) const {}
};
typedef _Float16 h16x2e __attribute__((ext_vector_type(2)));
typedef unsigned u32x2 __attribute__((ext_vector_type(2)));
__device__ __forceinline__ unsigned pk2h(float lo, float hi) { h16x2e v; v.x = (_Float16)lo; v.y = (_Float16)hi; return __builtin_bit_cast(unsigned, v); }
__device__ __forceinline__ float silu_f(float a) { return a * __builtin_amdgcn_rcpf(1.0f + __expf(-a)); }
__device__ __forceinline__ float sigm_f(float a) { return __builtin_amdgcn_rcpf(1.0f + __expf(-a)); }

struct EpiStoreF16 {
    static constexpr bool PERM = true, AFTER_DRAIN = false;
    bf16_t* O; int ldc; unsigned char* G8; const float* bg;
    __device__ __forceinline__ void operator()(const f32x4 (&acc)[2][2][4][2], const Unit& u, int wr, int wc, int fr, int fq) const {
        const int row0 = u.pm * BM + wr * 64 + fr, col0 = u.pn * BM + wc * 32 + 8 * fq;
        if (u.pn >= 9) {
            const int g0 = col0 - 9 * BM; f32x4 bv[2][2];
#pragma unroll
            for (int bj = 0; bj < 2; ++bj)
#pragma unroll
                for (int n = 0; n < 2; ++n) bv[bj][n] = *(const f32x4*)(bg + g0 + bj * HALF + 4 * n);
#pragma unroll
            for (int ai = 0; ai < 2; ++ai)
#pragma unroll
                for (int m = 0; m < 4; ++m) { unsigned char* rowp = G8 + (size_t)(row0 + ai * HALF + m * 16) * 4096 + g0;
#pragma unroll
                    for (int bj = 0; bj < 2; ++bj) { u32x2 w; unsigned q[8];
#pragma unroll
                        for (int n = 0; n < 2; ++n)
#pragma unroll
                            for (int i = 0; i < 4; ++i) q[4 * n + i] = (unsigned)(sigm_f(acc[ai][bj][m][n][i] + bv[bj][n][i]) * 255.0f + 0.5f);
                        w.x = q[0] | (q[1] << 8) | (q[2] << 16) | (q[3] << 24); w.y = q[4] | (q[5] << 8) | (q[6] << 16) | (q[7] << 24);
                        *(u32x2*)(rowp + bj * HALF) = w; } }
            return;
        }
#pragma unroll
        for (int ai = 0; ai < 2; ++ai)
#pragma unroll
            for (int m = 0; m < 4; ++m) { bf16_t* rowp = O + (size_t)(row0 + ai * HALF + m * 16) * ldc + col0;
#pragma unroll
                for (int bj = 0; bj < 2; ++bj) { const f32x4 v0 = acc[ai][bj][m][0], v1 = acc[ai][bj][m][1];
                    u32x4 w; w.x = pk2h(v0[0], v0[1]); w.y = pk2h(v0[2], v0[3]); w.z = pk2h(v1[0], v1[1]); w.w = pk2h(v1[2], v1[3]);
                    *(u32x4*)(rowp + bj * HALF) = w; } }
    }
};
struct EpiSwiGLU {
    static constexpr bool PERM = true, AFTER_DRAIN = false;
    bf16_t* O; int ldc;
    __device__ __forceinline__ void operator()(const f32x4 (&acc)[2][2][4][2], const Unit& u, int wr, int wc, int fr, int fq) const {
        const int row0 = u.pm * BM + wr * 64 + fr, col0 = u.pn * HALF + wc * 32 + 8 * fq;
#pragma unroll
        for (int ai = 0; ai < 2; ++ai)
#pragma unroll
            for (int m = 0; m < 4; ++m) { bf16_t* rowp = O + (size_t)(row0 + ai * HALF + m * 16) * ldc + col0;
                const f32x4 a0 = acc[ai][0][m][0], a1 = acc[ai][0][m][1], b0 = acc[ai][1][m][0], b1 = acc[ai][1][m][1];
                float r[8];
#pragma unroll
                for (int i = 0; i < 4; ++i) { r[i] = silu_f(a0[i]) * b0[i]; r[4 + i] = silu_f(a1[i]) * b1[i]; }
                u32x4 w; w.x = pk2h(r[0], r[1]); w.y = pk2h(r[2], r[3]); w.z = pk2h(r[4], r[5]); w.w = pk2h(r[6], r[7]);
                *(u32x4*)(rowp) = w; }
    }
};
struct EpiResidual {
    static constexpr bool PERM = true, AFTER_DRAIN = false;
    bf16_t* X; const float* sv_lat; const float* sv_ctx; float* part; float mul;
    __device__ __forceinline__ void operator()(const f32x4 (&acc)[2][2][4][2], const Unit& u, int wr, int wc, int fr, int fq) const {
        typedef _Float16 h16x8r __attribute__((ext_vector_type(8)));
        const float* sv = (u.pm == 0) ? sv_ctx : sv_lat;
        const int col0 = u.pn * BM + wc * 32 + 8 * fq;
        f32x4 s[2][2];
#pragma unroll
        for (int bj = 0; bj < 2; ++bj)
#pragma unroll
            for (int n = 0; n < 2; ++n) s[bj][n] = *(const f32x4*)(sv + col0 + bj * HALF + 4 * n) * mul;
        const bool slab = part && u.pm == 0;
#pragma unroll
        for (int aim = 0; aim < 4; ++aim) { const int ai = aim >> 1, m0 = (aim & 1) * 2;
            u32x4 xv[4][2];
            if (!slab) {
#pragma unroll
                for (int m = m0; m < m0 + 2; ++m) { const bf16_t* xp = X + (size_t)(u.pm * BM + ai * HALF + wr * 64 + m * 16 + fr) * 1024 + col0;
#pragma unroll
                    for (int bj = 0; bj < 2; ++bj) xv[m][bj] = *(const u32x4*)(xp + bj * HALF); } }
#pragma unroll
            for (int m = m0; m < m0 + 2; ++m) { const int rt = ai * HALF + wr * 64 + m * 16 + fr; bf16_t* xp = X + (size_t)(u.pm * BM + rt) * 1024 + col0;
#pragma unroll
                for (int bj = 0; bj < 2; ++bj) { const f32x4 d0 = s[bj][0] * acc[ai][bj][m][0], d1 = s[bj][1] * acc[ai][bj][m][1];
                    if (slab) { float* pp = part + ((size_t)u.ks * 256 + rt) * 1024 + col0 + bj * HALF; *(f32x4*)pp = d0; *(f32x4*)(pp + 4) = d1; }
                    else { const h16x8r xh = __builtin_bit_cast(h16x8r, xv[m][bj]); u32x4 w;
                        w.x = pk2h((float)xh[0] + d0[0], (float)xh[1] + d0[1]); w.y = pk2h((float)xh[2] + d0[2], (float)xh[3] + d0[3]);
                        w.z = pk2h((float)xh[4] + d1[0], (float)xh[5] + d1[1]); w.w = pk2h((float)xh[6] + d1[2], (float)xh[7] + d1[3]);
                        *(u32x4*)(xp + bj * HALF) = w; } } }
            asm volatile("" ::: "memory"); }
    }
};
struct EpiGate {
    static constexpr bool PERM = true, AFTER_DRAIN = false;
    const unsigned char* G; int ldg; float* S32; bf16_t* SH; float* part; int first, last;
    __device__ __forceinline__ void operator()(const f32x4 (&acc)[2][2][4][2], const Unit& u, int wr, int wc, int fr, int fq) const {
        typedef _Float16 h16x8e __attribute__((ext_vector_type(8)));
        const int col0 = u.pn * BM + wc * 32 + 8 * fq;
        const bool ctxu = u.pm == 0, rd = !first && !ctxu;
#pragma unroll
        for (int ai = 0; ai < 2; ++ai) {
            u32x2 gv[4][2]; u32x4 pv[4][2];
#pragma unroll
            for (int m = 0; m < 4; ++m) { const size_t row = (size_t)(u.pm * BM + ai * HALF + wr * 64 + m * 16 + fr);
#pragma unroll
                for (int bj = 0; bj < 2; ++bj) { const int c = col0 + bj * HALF; gv[m][bj] = *(const u32x2*)(G + row * ldg + c);
                    if (rd) pv[m][bj] = *(const u32x4*)(SH + row * 1024 + c); } }
#pragma unroll
            for (int m = 0; m < 4; ++m) { const size_t row = (size_t)(u.pm * BM + ai * HALF + wr * 64 + m * 16 + fr);
#pragma unroll
                for (int bj = 0; bj < 2; ++bj) { const int c = col0 + bj * HALF; float v[8];
#pragma unroll
                    for (int n = 0; n < 2; ++n)
#pragma unroll
                        for (int i = 0; i < 4; ++i) { const unsigned gw = n ? gv[m][bj].y : gv[m][bj].x; v[4 * n + i] = (float)((gw >> (8 * i)) & 255u) * (1.0f / 255.0f) * acc[ai][bj][m][n][i]; }
                    if (ctxu) { *(f32x4*)(part + row * 1024 + c) = (f32x4){v[0], v[1], v[2], v[3]}; *(f32x4*)(part + row * 1024 + c + 4) = (f32x4){v[4], v[5], v[6], v[7]}; continue; }
                    if (rd) { const h16x8e ph = __builtin_bit_cast(h16x8e, pv[m][bj]);
#pragma unroll
                        for (int i = 0; i < 8; ++i) v[i] += (float)ph[i]; }
                    u32x4 w; w.x = pk2h(v[0], v[1]); w.y = pk2h(v[2], v[3]); w.z = pk2h(v[4], v[5]); w.w = pk2h(v[6], v[7]);
                    *(u32x4*)(SH + row * 1024 + c) = w; } }
            asm volatile("" ::: "memory"); }
    }
};


struct CtxSplitOrder {
    int G, c, ntf, S, coff;
    __host__ __device__ void init(int K, int S_, int G_, int c_, int coff_) { G = G_; c = c_; ntf = K / BK; S = S_; coff = coff_; }
    __host__ __device__ __forceinline__ bool next(int i, Unit& u) const {
        const int L = i * G + c, j = L - 256 - coff, xcd = L & 7, off = L >> 3, nts = ntf / S; const bool lat = L < 256;
        u.pm = lat ? 1 + xcd * 8 + (off & 7) : 0; u.pn = lat ? (off >> 3) : (j & 3); u.nt = lat ? ntf : nts; u.ks = lat ? 0 : (j >> 2); u.koff = u.ks * nts * BK;
        return lat || (j >= 0 && j < 4 * S);
    }
    __device__ __forceinline__ void a_ready(const Unit&) const {}
    __device__ __forceinline__ void done(const Unit&) const {}
};


template <class Epi, class Sched, bool ALIGN_EPI = false, bool SP2 = false>
__device__ __forceinline__ void gemm_phase(PG8_LAS unsigned char* lds, const Gemm g, const Sched& S, const Epi& E) {
    const int tid = fresh_tid(), wid = __builtin_amdgcn_readfirstlane(tid >> 6), lane = tid & 63, wr = wid >> 2, wc = wid & 3, fr = lane & 15, fq = lane >> 4;
    const int K = g.K;
    unsigned voffA[2], voffB[2];
#pragma unroll
    for (int i = 0; i < 2; ++i) { int R, C; stage_rc(tid * 16 + i * 8192, R, C); const int Rb = Epi::PERM ? ((R & ~31) + perm32(R & 31)) : R;
        voffA[i] = (unsigned)(R * K + C) * 2u; voffB[i] = (unsigned)(Rb * K + C) * 2u; }
    const size_t kstep = (size_t)(BK * 2);
    const size_t hstep = (size_t)HALF * K * 2;
    const size_t tstep = 2 * hstep;
    const unsigned ldsw = (unsigned)wid * 1024u;
    const int aoff = lds_byte(wr * 64 + fr, fq * 8), boff = lds_byte(wc * 32 + fr, fq * 8);
#define PG8_SA(b, h) (((b) * 2 + (h)) * HTB)
#define PG8_SB(b, h) ((4 + (b) * 2 + (h)) * HTB)
#define PG8_STAGE(bufoff, gbase, voff) do { _Pragma("unroll") for (int _i = 0; _i < 2; ++_i) \
        __builtin_amdgcn_global_load_lds((const unsigned*)((const char*)(gbase) + (voff)[_i]), (PG8_LAS unsigned*)(lds + (bufoff) + ldsw + _i * 8192), 16, 0, 0); } while (0)
#define PG8_LDA(dst, b, h) do { _Pragma("unroll") for (int m = 0; m < 4; ++m) _Pragma("unroll") for (int k = 0; k < 2; ++k) dst[m][k] = *(const PG8_LAS bf16x8*)(lds + PG8_SA(b, h) + aoff + m * 2048 + k * 1024); } while (0)
#define PG8_LDB(dst, b, h) do { _Pragma("unroll") for (int n = 0; n < 2; ++n) _Pragma("unroll") for (int k = 0; k < 2; ++k) dst[n][k] = *(const PG8_LAS bf16x8*)(lds + PG8_SB(b, h) + boff + n * 2048 + k * 1024); } while (0)
#define PG8_MMA(ai, bj, At, Bt) do { __builtin_amdgcn_s_setprio(1); _Pragma("unroll") for (int m = 0; m < 4; ++m) _Pragma("unroll") for (int n = 0; n < 2; ++n) _Pragma("unroll") for (int k = 0; k < 2; ++k) \
        acc[ai][bj][m][n] = __builtin_amdgcn_mfma_f32_16x16x32_f16(Bt[n][k], At[m][k], acc[ai][bj][m][n], 0, 0, 0); __builtin_amdgcn_s_setprio(0); } while (0)
#define PG8_WAIT_V(n) asm volatile("s_waitcnt vmcnt(" #n ")" ::: "memory")
#define PG8_WAIT_L(n) asm volatile("s_waitcnt lgkmcnt(" #n ")" ::: "memory")
#define PG8_BAR __builtin_amdgcn_s_barrier()
#define PG8_SCHED __builtin_amdgcn_sched_barrier(0)
    Unit cur, nxt; int ui = 0;
    if (!S.next(0, cur)) return;
    f32x4 acc[2][2][4][2];
#pragma unroll
    for (int a = 0; a < 2; ++a)
#pragma unroll
        for (int b = 0; b < 2; ++b)
#pragma unroll
            for (int m = 0; m < 4; ++m)
#pragma unroll
                for (int n = 0; n < 2; ++n) acc[a][b][m][n] = (f32x4){0.f, 0.f, 0.f, 0.f};
    bf16x8 At[4][2], B0[2][2], B1[2][2];
    const char* cA = (const char*)g.A + (size_t)cur.pm * tstep + (size_t)cur.koff * 2; const char* cB = (const char*)g.Bt + (size_t)cur.pn * tstep + (size_t)cur.koff * 2;
    S.a_ready(cur);
    if constexpr (SP2) {
        PG8_STAGE(PG8_SB(0, 0), cB, voffB); PG8_STAGE(PG8_SB(0, 1), cB + hstep, voffB); PG8_STAGE(PG8_SA(0, 0), cA, voffA); PG8_STAGE(PG8_SA(0, 1), cA + hstep, voffA);
        if (wr == 1) PG8_BAR;
        PG8_WAIT_V(2); PG8_BAR;
        PG8_STAGE(PG8_SB(1, 0), cB + kstep, voffB); PG8_STAGE(PG8_SA(1, 0), cA + kstep, voffA); PG8_STAGE(PG8_SB(1, 1), cB + hstep + kstep, voffB);
        PG8_WAIT_V(6); PG8_BAR;
    } else {
        PG8_STAGE(PG8_SB(0, 0), cB, voffB); PG8_STAGE(PG8_SA(0, 0), cA, voffA); PG8_STAGE(PG8_SB(0, 1), cB + hstep, voffB); PG8_STAGE(PG8_SA(0, 1), cA + hstep, voffA);
        if (wr == 1) PG8_BAR;
        PG8_WAIT_V(4); PG8_BAR;
        PG8_STAGE(PG8_SB(1, 0), cB + kstep, voffB); PG8_STAGE(PG8_SA(1, 0), cA + kstep, voffA); PG8_STAGE(PG8_SB(1, 1), cB + hstep + kstep, voffB);
        PG8_WAIT_V(6); PG8_BAR;
    }
    for (;;) {
        const bool has_next = S.next(ui + 1, nxt);
        const char* nA = has_next ? (const char*)g.A + (size_t)nxt.pm * tstep + (size_t)nxt.koff * 2 : cA; const char* nB = has_next ? (const char*)g.Bt + (size_t)nxt.pn * tstep + (size_t)nxt.koff * 2 : cB;
        const int nt = cur.nt;
        for (int t = 0; t < nt; t += 2) {
            const bool last = (t == nt - 2);
            const char* a1 = cA + (size_t)(t + 1) * kstep;
            const char* a2 = last ? nA : cA + (size_t)(t + 2) * kstep; const char* b2 = last ? nB : cB + (size_t)(t + 2) * kstep;
            const char* a3 = a2 + kstep; const char* b3 = b2 + kstep;
            if (last && has_next) S.a_ready(nxt);
            if constexpr (SP2) {
            PG8_LDB(B0, 0, 0); PG8_LDB(B1, 0, 1); PG8_SCHED; PG8_LDA(At, 0, 0); PG8_STAGE(PG8_SA(1, 1), a1 + hstep, voffA);
            PG8_WAIT_V(8); PG8_WAIT_L(0); PG8_BAR; PG8_MMA(0, 0, At, B0); PG8_MMA(0, 1, At, B1); PG8_BAR; PG8_SCHED;
            PG8_LDA(At, 0, 1); PG8_STAGE(PG8_SB(0, 0), b2, voffB); PG8_STAGE(PG8_SB(0, 1), b2 + hstep, voffB); PG8_STAGE(PG8_SA(0, 0), a2, voffA);
            PG8_WAIT_V(8); PG8_WAIT_L(0); PG8_BAR; PG8_MMA(1, 0, At, B0); PG8_MMA(1, 1, At, B1); PG8_BAR; PG8_SCHED;
            PG8_LDB(B0, 1, 0); PG8_LDB(B1, 1, 1); PG8_SCHED; PG8_LDA(At, 1, 0); PG8_STAGE(PG8_SA(0, 1), a2 + hstep, voffA);
            PG8_WAIT_V(8); PG8_WAIT_L(0); PG8_BAR; PG8_MMA(0, 0, At, B0); PG8_MMA(0, 1, At, B1); PG8_BAR; PG8_SCHED;
            PG8_LDA(At, 1, 1); PG8_STAGE(PG8_SB(1, 0), b3, voffB); PG8_STAGE(PG8_SB(1, 1), b3 + hstep, voffB); PG8_STAGE(PG8_SA(1, 0), a3, voffA);
            PG8_WAIT_V(8); PG8_WAIT_L(0); PG8_BAR; PG8_MMA(1, 0, At, B0); PG8_MMA(1, 1, At, B1); PG8_BAR; PG8_SCHED;
            } else {
            PG8_LDB(B0, 0, 0); PG8_SCHED; PG8_LDA(At, 0, 0); PG8_STAGE(PG8_SA(1, 1), a1 + hstep, voffA);
            PG8_WAIT_L(8); PG8_BAR; PG8_WAIT_L(0); PG8_MMA(0, 0, At, B0); PG8_BAR; PG8_SCHED;
            PG8_LDB(B1, 0, 1); PG8_STAGE(PG8_SB(0, 0), b2, voffB);
            PG8_BAR; PG8_WAIT_L(0); PG8_MMA(0, 1, At, B1); PG8_BAR;
            PG8_LDA(At, 0, 1); PG8_STAGE(PG8_SA(0, 0), a2, voffA);
            PG8_BAR; PG8_WAIT_L(0); PG8_MMA(1, 0, At, B0); PG8_BAR; PG8_SCHED;
            PG8_STAGE(PG8_SB(0, 1), b2 + hstep, voffB);
            PG8_WAIT_V(6); PG8_BAR; PG8_MMA(1, 1, At, B1); PG8_BAR;
            PG8_LDB(B0, 1, 0); PG8_SCHED; PG8_LDA(At, 1, 0); PG8_STAGE(PG8_SA(0, 1), a2 + hstep, voffA);
            PG8_WAIT_L(8); PG8_BAR; PG8_WAIT_L(0); PG8_MMA(0, 0, At, B0); PG8_BAR; PG8_SCHED;
            PG8_LDB(B1, 1, 1); PG8_STAGE(PG8_SB(1, 0), b3, voffB);
            PG8_BAR; PG8_WAIT_L(0); PG8_MMA(0, 1, At, B1); PG8_BAR;
            PG8_LDA(At, 1, 1); PG8_STAGE(PG8_SA(1, 0), a3, voffA);
            PG8_BAR; PG8_WAIT_L(0); PG8_MMA(1, 0, At, B0); PG8_BAR; PG8_SCHED;
            PG8_STAGE(PG8_SB(1, 1), b3 + hstep, voffB);
            PG8_WAIT_V(6); PG8_BAR; PG8_MMA(1, 1, At, B1); PG8_BAR;
            }
        }
        if constexpr (ALIGN_EPI) { if (wr == 0) PG8_BAR; }
        if constexpr (!Epi::AFTER_DRAIN) { E(acc, cur, wr, wc, fr, fq); S.done(cur); }
        if (!has_next) break;
#pragma unroll
        for (int a = 0; a < 2; ++a)
#pragma unroll
            for (int b = 0; b < 2; ++b)
#pragma unroll
                for (int m = 0; m < 4; ++m)
#pragma unroll
                    for (int n = 0; n < 2; ++n) acc[a][b][m][n] = (f32x4){0.f, 0.f, 0.f, 0.f};
        cur = nxt; cA = nA; cB = nB; ++ui;
        if constexpr (ALIGN_EPI) { if (wr == 1) PG8_BAR; }
    }
    PG8_WAIT_V(0);
    if constexpr (!ALIGN_EPI) { if (wr == 0) PG8_BAR; }
    PG8_BAR;
    if constexpr (Epi::AFTER_DRAIN) { E.fused(acc, cur, wr, wc, fr, fq, lds, wid, lane); S.done(cur); }
#undef PG8_SA
#undef PG8_SB
#undef PG8_STAGE
#undef PG8_LDA
#undef PG8_LDB
#undef PG8_MMA
#undef PG8_WAIT_V
#undef PG8_WAIT_L
#undef PG8_BAR
#undef PG8_SCHED
}
}
#include <cmath>
namespace attn_body {
using bf16=_Float16;
using bf16x8=__attribute__((ext_vector_type(8)))short;
using s16x4=__attribute__((ext_vector_type(4)))short;
using f32x16=__attribute__((ext_vector_type(16)))float;
using u32x4=__attribute__((ext_vector_type(4)))unsigned;
constexpr int D=64,QP=512,KP=128;
constexpr int NW=8,QBLK=32,QB=QBLK*NW,KVBLK=64;
constexpr int ATTN_UNIT_ROWS=QB;
__device__ __forceinline__ int crow(int r,int hi){return (r&3)+8*(r>>2)+4*hi;}
#define SBAR() __builtin_amdgcn_sched_barrier(0)
__device__ __forceinline__ void cmask(f32x16&p0,f32x16&p1,int jb,int qrel,int hi){
  const float NEG=-INFINITY; int kb=64*jb+4*hi;
  #pragma unroll
  for(int r=0;r<16;++r){int kv=kb+(r&3)+8*(r>>2); if(kv>qrel)p0[r]=NEG; if(kv+32>qrel)p1[r]=NEG;}
}

constexpr int NSLOT=3, SLOTB=8192;
constexpr int LDS_K=0, LDS_V=NSLOT*SLOTB, LDS_WS=2*NSLOT*SLOTB, LDS_OST=LDS_WS+NW*64*4, LDS_BYTES=LDS_OST+NW*4096;
constexpr float C2=0.125f*1.4426950408889634f;
__device__ __forceinline__ void glds16(const void*gsrc,unsigned lds_dst){unsigned keep;
  asm volatile("s_mov_b32 %0, m0\n\ts_mov_b32 m0, %2\n\ts_nop 0\n\tglobal_load_lds_dwordx4 %1, off\n\ts_mov_b32 m0, %0":"=&s"(keep):"v"(gsrc),"s"(lds_dst):"memory");}
__device__ __forceinline__ float max3f(float a,float b,float c){float r;asm("v_max3_f32 %0, %1, %2, %3":"=v"(r):"v"(a),"v"(b),"v"(c));return r;}
__device__ __forceinline__ float max2f(float a,float b){float r;asm("v_max_f32_e32 %0, %1, %2":"=v"(r):"v"(a),"v"(b));return r;}
__device__ __forceinline__ float fadd_s(float a,float b){float r;asm("v_add_f32_e32 %0, %1, %2":"=v"(r):"v"(a),"v"(b));return r;}
__device__ __forceinline__ float fsub_s(float a,float b){float r;asm("v_sub_f32_e32 %0, %1, %2":"=v"(r):"v"(a),"v"(b));return r;}
typedef _Float16 h16x8_t __attribute__((ext_vector_type(8)));
__device__ __forceinline__ f32x16 mfma32h(bf16x8 a,bf16x8 b,f32x16 c,int,int,int){return __builtin_amdgcn_mfma_f32_32x32x16_f16(__builtin_bit_cast(h16x8_t,a),__builtin_bit_cast(h16x8_t,b),c,0,0,0);}
__device__ __forceinline__ unsigned cvtpk_s(float lo,float hi){return __builtin_bit_cast(unsigned,__builtin_amdgcn_cvt_pkrtz(lo,hi));}
#define WAIT_BAR(N) asm volatile("s_waitcnt vmcnt(" #N ") lgkmcnt(0)\n\ts_barrier":::"memory")

__device__ __forceinline__ void qkt(f32x16&p0,f32x16&p1,const char*Kslot,const bf16x8*qr,const f32x16&negm,int r32,int hi){
  const char*kb=Kslot+hi*1024+r32*16;
  #pragma unroll
  for(int d0=0;d0<4;++d0){
    const bf16x8 b0=*reinterpret_cast<const bf16x8*>(kb+d0*2048);
    const bf16x8 b1=*reinterpret_cast<const bf16x8*>(kb+d0*2048+512);
    if(d0==0){p0=mfma32h(b0,qr[0],negm,0,0,0);p1=mfma32h(b1,qr[0],negm,0,0,0);}
    else{p0=mfma32h(b0,qr[d0],p0,0,0,0);p1=mfma32h(b1,qr[d0],p1,0,0,0);}}
}
typedef __attribute__((address_space(3))) const char* lds_cptr;
typedef short v4i16_t __attribute__((ext_vector_type(4)));
__device__ __forceinline__ void kload8(bf16x8*kf,lds_cptr kp){
  kf[0]=*(const __attribute__((address_space(3))) bf16x8*)(kp);      kf[1]=*(const __attribute__((address_space(3))) bf16x8*)(kp+512);
  kf[2]=*(const __attribute__((address_space(3))) bf16x8*)(kp+2048); kf[3]=*(const __attribute__((address_space(3))) bf16x8*)(kp+2560);
  kf[4]=*(const __attribute__((address_space(3))) bf16x8*)(kp+4096); kf[5]=*(const __attribute__((address_space(3))) bf16x8*)(kp+4608);
  kf[6]=*(const __attribute__((address_space(3))) bf16x8*)(kp+6144); kf[7]=*(const __attribute__((address_space(3))) bf16x8*)(kp+6656);
}
__device__ __forceinline__ void kload2(bf16x8*kf,lds_cptr kp,int j){ kf[2*j]=*(const __attribute__((address_space(3))) bf16x8*)(kp+j*2048); kf[2*j+1]=*(const __attribute__((address_space(3))) bf16x8*)(kp+j*2048+512); }
__device__ __forceinline__ s16x4 vtr(lds_cptr p){ return __builtin_bit_cast(s16x4,__builtin_amdgcn_ds_read_tr16_b64_v4i16((__attribute__((address_space(3))) v4i16_t*)p)); }
__device__ __forceinline__ float rowmax(const f32x16&p0,const f32x16&p1){
  float a=max3f(p0[0],p0[1],p1[0]),b=max3f(p0[2],p0[3],p1[1]);a=max3f(a,p1[2],p1[3]);
  #pragma unroll
  for(int r=4;r<16;r+=4){a=max3f(a,p0[r],p0[r+1]);b=max3f(b,p0[r+2],p0[r+3]);a=max3f(a,p1[r],p1[r+1]);b=max3f(b,p1[r+2],p1[r+3]);}
  const float m=max2f(a,b);
  auto rr=__builtin_amdgcn_permlane32_swap(__float_as_uint(m),__float_as_uint(m),false,false);
  return max2f(__uint_as_float(rr[0]),__uint_as_float(rr[1]));
}
__device__ __forceinline__ void pv(f32x16*o,int vb,bf16x8 pa0,bf16x8 pa1,bf16x8 pa2,bf16x8 pa3){
  #pragma unroll
  for(int d0=0;d0<2;++d0){s16x4 lo[4],hi[4];
    #pragma unroll
    for(int ks=0;ks<4;++ks){
      asm volatile("ds_read_b64_tr_b16 %0,%1 offset:%c2":"=&v"(lo[ks]):"v"(vb),"i"(d0*4096+ks*1024):"memory");
      asm volatile("ds_read_b64_tr_b16 %0,%1 offset:%c2":"=&v"(hi[ks]):"v"(vb),"i"(d0*4096+ks*1024+512):"memory");}
    asm volatile("s_waitcnt lgkmcnt(0)":::"memory");SBAR();
    #define PK(k) (bf16x8){lo[k][0],lo[k][1],lo[k][2],lo[k][3],hi[k][0],hi[k][1],hi[k][2],hi[k][3]}
    o[d0]=mfma32h(pa0,PK(0),o[d0],0,0,0);
    o[d0]=mfma32h(pa1,PK(1),o[d0],0,0,0);
    o[d0]=mfma32h(pa2,PK(2),o[d0],0,0,0);
    o[d0]=mfma32h(pa3,PK(3),o[d0],0,0,0);
    #undef PK
  }
}

#ifndef ATTN_STORE16
#define ATTN_STORE16(p,v) (*(u32x4*)(p)=(v))
#endif
template<int THRL> __device__ __forceinline__ void attn_unit(int h,int qb,int NT,const bf16*Q,const bf16*__restrict__ K,const bf16*__restrict__ V,bf16*O,char*shm){
  const int tid=fresh_tid(),lane=tid&63,r32=lane&31,hi=lane>>5; const int wid=__builtin_amdgcn_readfirstlane(tid>>6);
  const int q0=qb*QB;
  const bf16*Qw=Q+(long)(q0+wid*QBLK)*QP+h*D;
  const bf16*Kh=K+(h>>2)*D,*Vh=V+(h>>2)*D;
  const unsigned lds0=(unsigned)(uintptr_t)shm;
  float*wsf=(float*)(shm+LDS_WS)+wid*64;
  const bf16*ksrc=Kh+(long)lane*KP+wid*8;
  const bf16*vsrc=Vh+(long)(16*(wid&3)+(lane>>2))*KP+(wid>>2)*32+(lane&3)*8;
  const unsigned kdst=lds0+LDS_K+wid*1024, vdst=lds0+LDS_V+wid*1024;
  #define DMA_K(t,slot) glds16(ksrc+(long)(t)*KVBLK*KP,(unsigned)__builtin_amdgcn_readfirstlane(kdst+(slot)))
  #define DMA_V(t,slot) glds16(vsrc+(long)(t)*KVBLK*KP,(unsigned)__builtin_amdgcn_readfirstlane(vdst+(slot)))
  const int vb0=(int)(lds0+LDS_V)+((lane>>4)&1)*32+(lane&3)*8+(4*hi+((lane&15)>>2))*64;
  const char*Kbase=shm+LDS_K; bf16x8 kf[8];
  const lds_cptr shm3=(lds_cptr)shm; const lds_cptr kp0=shm3+LDS_K+hi*1024+r32*16; const lds_cptr vp0=shm3+LDS_V+((lane>>4)&1)*32+(lane&3)*8+(4*hi+((lane&15)>>2))*64;
  DMA_K(0,0);DMA_V(0,0);DMA_K(1,SLOTB);
  bf16x8 qr[4];
  #pragma unroll
  for(int d0=0;d0<4;++d0)qr[d0]=*reinterpret_cast<const bf16x8*>(&Qw[(long)r32*QP+d0*16+hi*8]);
  float mhat=0.f,l_reg=0.f;f32x16 o[2];o[0]=f32x16{};o[1]=f32x16{};f32x16 negm=f32x16{};asm volatile("":"+v"(negm));
  const int qrel=wid*QBLK+r32;
  #define CMASK(P0,P1,t) do{}while(0)
  bool resc=false;
  #define START(P0,P1) do{ const float rm=rowmax(P0,P1); resc=false; \
    { const float dl=rm; mhat=fadd_s(mhat,dl); \
      _Pragma("unroll") for(int r=0;r<16;++r){P0[r]=fsub_s(P0[r],dl);P1[r]=fsub_s(P1[r],dl);} \
      _Pragma("unroll") for(int r=0;r<16;++r)negm[r]=-mhat; asm volatile("":"+v"(negm)); } \
    _Pragma("unroll") for(int r=0;r<16;++r)P0[r]=__builtin_amdgcn_exp2f(P0[r]); }while(0)
  #define RESC() do{ if(resc){ asm volatile("s_waitcnt lgkmcnt(0)":::"memory"); \
      _Pragma("unroll") for(int d_=0;d_<2;++d_) _Pragma("unroll") for(int r=0;r<16;++r)o[d_][r]*=wsf[crow(r,hi)]; } }while(0)
  f32x16 pA0,pA1,pB0,pB1;
  int sl_prev=0,sl_cur=0,sl_next=SLOTB;
  #define ROT() do{sl_prev=sl_cur;sl_cur=sl_next;sl_next=(sl_next==(NSLOT-1)*SLOTB)?0:sl_next+SLOTB;}while(0)
  DMA_K(2,2*SLOTB);
  WAIT_BAR(3);
  qkt(pA0,pA1,Kbase,qr,negm,r32,hi);asm volatile("s_nop 15\n\ts_nop 7":"+v"(pA0),"+v"(pA1));CMASK(pA0,pA1,0);
  START(pA0,pA1);
  _Pragma("unroll") for(int r=0;r<16;++r)pA1[r]=__builtin_amdgcn_exp2f(pA1[r]);
  WAIT_BAR(0);
  DMA_K(3,0);DMA_V(1,SLOTB);
  ROT();
  kload8(kf,kp0+sl_cur);
  WAIT_BAR(2);
  s16x4 vlo[8],vhi[8]; u32x4 pw0,pw1,pw2,pw3;
  #define PKW(P,B) cvtpk_s(P[B],P[B+1])
  #define PAF(k) __builtin_bit_cast(bf16x8,pw##k)
  #define VFR(i) (bf16x8){vlo[i][0],vlo[i][1],vlo[i][2],vlo[i][3],vhi[i][0],vhi[i][1],vhi[i][2],vhi[i][3]}
  #define PIN(x) asm volatile("":"+v"(x))
  #define MX3(a,b,c) __builtin_fmaxf(__builtin_fmaxf((a),(b)),(c))
  #define GAPA(MF,A0,A1,A2,A3,W0,W1,PW) do{ MF; sacc+=A0; sacc+=A1; sacc+=A2; sacc+=A3; PIN(sacc); W0; W1; PIN(PW); SBAR(); }while(0)
  #define EX(v) __builtin_amdgcn_exp2f(v)
  #define GAPB(MF,X,B) do{ MF; X[B]=EX(X[B]); X[B+1]=EX(X[B+1]); X[B+2]=EX(X[B+2]); X[B+3]=EX(X[B+3]); PIN(X); SBAR(); }while(0)
  #define VRD(i) do{ vlo[i]=vtr(vp_+(((i)>>2)*4096+((i)&3)*1024)); vhi[i]=vtr(vp_+(((i)>>2)*4096+((i)&3)*1024+512)); }while(0)
  #define KRD(G,j) do{ if(G){ kload2(kf,kp0+sl_next,j); SBAR(); } }while(0)
  #define STEP(C0,C1,P0,P1,t,GK,GV,GL) do{ SBAR(); \
    const lds_cptr vp_=vp0+sl_prev; \
    VRD(0); SBAR(); float sacc=(P0[0]+P0[1]); \
    GAPA(C0=mfma32h(kf[0],qr[0],negm,0,0,0), P0[2],P0[3],P0[4],P0[5],     pw0[0]=PKW(P0,0), pw0[1]=PKW(P0,2), pw0); \
    VRD(4); SBAR(); GAPA(C1=mfma32h(kf[1],qr[0],negm,0,0,0), P0[6],P0[7],P0[8],P0[9],     pw0[2]=PKW(P0,4), pw0[3]=PKW(P0,6), pw0); \
    VRD(1); SBAR(); GAPA(C0=mfma32h(kf[2],qr[1],C0,0,0,0),   P0[10],P0[11],P0[12],P0[13], pw1[0]=PKW(P0,8), pw1[1]=PKW(P0,10), pw1); \
    VRD(5); SBAR(); GAPA(C1=mfma32h(kf[3],qr[1],C1,0,0,0),   P0[14],P0[15],P1[0],P1[1],   pw1[2]=PKW(P0,12),pw1[3]=PKW(P0,14), pw1); \
    VRD(2); SBAR(); GAPA(C0=mfma32h(kf[4],qr[2],C0,0,0,0),   P1[2],P1[3],P1[4],P1[5],     pw2[0]=PKW(P1,0), pw2[1]=PKW(P1,2), pw2); \
    VRD(6); SBAR(); GAPA(C1=mfma32h(kf[5],qr[2],C1,0,0,0),   P1[6],P1[7],P1[8],P1[9],     pw2[2]=PKW(P1,4), pw2[3]=PKW(P1,6), pw2); \
    VRD(3); SBAR(); GAPA(C0=mfma32h(kf[6],qr[3],C0,0,0,0),   P1[10],P1[11],P1[12],P1[13], pw3[0]=PKW(P1,8), pw3[1]=PKW(P1,10), pw3); \
    VRD(7); SBAR(); GAPA(C1=mfma32h(kf[7],qr[3],C1,0,0,0),   P1[14],P1[15],0.f,0.f,       pw3[2]=PKW(P1,12),pw3[3]=PKW(P1,14), pw3); \
    l_reg+=sacc; \
    if(GK){DMA_K((t)+3,sl_cur);} if(GV){DMA_V((t)+1,sl_next);} \
    CMASK(C0,C1,t); \
    { float a=MX3(C0[0],C0[1],C1[0]),b=MX3(C0[2],C0[3],C1[1]); a=MX3(a,C1[2],C1[3]); \
      _Pragma("unroll") for(int r=4;r<16;r+=4){a=MX3(a,C0[r],C0[r+1]);b=MX3(b,C0[r+2],C0[r+3]);a=MX3(a,C1[r],C1[r+1]);b=MX3(b,C1[r+2],C1[r+3]);} \
      float rm=__builtin_fmaxf(a,b); { auto rr=__builtin_amdgcn_permlane32_swap(__float_as_uint(rm),__float_as_uint(rm),false,false); rm=__builtin_fmaxf(__uint_as_float(rr[0]),__uint_as_float(rr[1])); } \
      resc=false; \
      if(__builtin_expect(__any(rm>(float)THRL),0)){ const float dl=__builtin_fmaxf(rm,0.f); mhat+=dl; \
        _Pragma("unroll") for(int r=0;r<16;++r){C0[r]-=dl;C1[r]-=dl;} \
        _Pragma("unroll") for(int r=0;r<16;++r)negm[r]=-mhat; asm volatile("":"+v"(negm)); \
        const float f=__builtin_amdgcn_exp2f(-dl); l_reg*=f; if(hi==0)wsf[r32]=f; resc=true; } } \
    SBAR(); \
    GAPB(o[0]=mfma32h(PAF(0),VFR(0),o[0],0,0,0), C0,0); \
    GAPB(o[1]=mfma32h(PAF(0),VFR(4),o[1],0,0,0), C0,4); \
    KRD(GL,0); GAPB(o[0]=mfma32h(PAF(1),VFR(1),o[0],0,0,0), C0,8); \
    KRD(GL,1); GAPB(o[1]=mfma32h(PAF(1),VFR(5),o[1],0,0,0), C0,12); \
    KRD(GL,2); GAPB(o[0]=mfma32h(PAF(2),VFR(2),o[0],0,0,0), C1,0); \
    KRD(GL,3); GAPB(o[1]=mfma32h(PAF(2),VFR(6),o[1],0,0,0), C1,4); \
    GAPB(o[0]=mfma32h(PAF(3),VFR(3),o[0],0,0,0), C1,8); \
    GAPB(o[1]=mfma32h(PAF(3),VFR(7),o[1],0,0,0), C1,12); \
    }while(0)
  int t=1;
  #undef CMASK
  #define CMASK(P0,P1,t) do{}while(0)
  for(;t+5<NT;t+=2){
    STEP(pB0,pB1,pA0,pA1,t,true,true,true);     WAIT_BAR(2); RESC(); ROT();
    STEP(pA0,pA1,pB0,pB1,t+1,true,true,true);   WAIT_BAR(2); RESC(); ROT();
  }
  #undef CMASK
  #define CMASK(P0,P1,t) do{}while(0)
  #define ENDW(tt) do{ if((tt)+3<NT){WAIT_BAR(2);} else if((tt)+2<NT){WAIT_BAR(1);} else {WAIT_BAR(0);} }while(0)
  for(;t+1<NT;t+=2){
    STEP(pB0,pB1,pA0,pA1,t,(t+3<NT),(t+1<NT),(t+1<NT));       ENDW(t);   RESC(); ROT();
    STEP(pA0,pA1,pB0,pB1,t+1,(t+4<NT),(t+2<NT),(t+2<NT));     ENDW(t+1); RESC(); ROT();
  }
  STEP(pB0,pB1,pA0,pA1,NT-1,false,false,false); RESC();
  { float sacc=pB0[0]+pB0[1]; _Pragma("unroll") for(int r=2;r<16;++r)sacc+=pB0[r]; _Pragma("unroll") for(int r=0;r<16;++r)sacc+=pB1[r]; l_reg+=sacc;
    pw0=(u32x4){PKW(pB0,0),PKW(pB0,2),PKW(pB0,4),PKW(pB0,6)};pw1=(u32x4){PKW(pB0,8),PKW(pB0,10),PKW(pB0,12),PKW(pB0,14)};pw2=(u32x4){PKW(pB1,0),PKW(pB1,2),PKW(pB1,4),PKW(pB1,6)};pw3=(u32x4){PKW(pB1,8),PKW(pB1,10),PKW(pB1,12),PKW(pB1,14)};
    SBAR(); pv(o,vb0+sl_cur,PAF(0),PAF(1),PAF(2),PAF(3)); }
  #undef PKW
  #undef PAF
  #undef VFR
  #undef PIN
  #undef MX3
  #undef GAPA
  #undef GAPB
  #undef EX
  #undef VRD
  #undef KRD
  #undef STEP
  #undef ENDW
  {auto rr=__builtin_amdgcn_permlane32_swap(__float_as_uint(l_reg),__float_as_uint(l_reg),false,false);l_reg=__uint_as_float(rr[0])+__uint_as_float(rr[1]);}
  if(hi==0)wsf[32+r32]=l_reg;asm volatile("s_waitcnt lgkmcnt(0)":::"memory");
  float rli[16];
  #pragma unroll
  for(int r=0;r<16;++r)rli[r]=__builtin_amdgcn_rcpf(wsf[32+crow(r,hi)]);
  bf16*Ow=O+(long)(q0+wid*QBLK)*QP+h*D;
  { bf16*stg=(bf16*)(shm+LDS_OST)+wid*2048;
    #pragma unroll
    for(int r=0;r<16;++r){const int orow=crow(r,hi);
      #pragma unroll
      for(int d0=0;d0<2;++d0)stg[orow*64+d0*32+r32]=(_Float16)(o[d0][r]*rli[r]);}
    asm volatile("s_waitcnt lgkmcnt(0)":::"memory");
    #pragma unroll
    for(int i=0;i<4;++i){const int row=i*8+(lane>>3),ch=lane&7; const u32x4 v=*(const u32x4*)(stg+row*64+ch*8); ATTN_STORE16(Ow+(long)row*QP+ch*8,v);} }
  asm volatile("s_waitcnt lgkmcnt(0)\n\ts_barrier":::"memory");
  #undef DMA_K
  #undef DMA_V
  #undef CMASK
  #undef START
  #undef RESC
  #undef ROT
}
constexpr int ATTN_LDS_BYTES=LDS_BYTES;
#undef SBAR
#undef WAIT_BAR
}
#ifndef LAS
#define LAS __attribute__((address_space(3)))
#endif
#define XB_TMO      128
#define XB_XCNT(j)  (256  + 64 * (j))
#define XB_XSUB(j)  (1280 + 64 * (j))
#define XB_XGEN(j)  (2304 + 64 * (j))
#define XB_TOP      3328
#define XB_TOPGEN   3392
#define XCD_BAR_WORDS 3456
#define XB_SPIN_CAP (1u << 18)

__device__ __forceinline__ unsigned xb_ld(unsigned* p)              { return __hip_atomic_load(p, __ATOMIC_RELAXED, __HIP_MEMORY_SCOPE_AGENT); }
__device__ __forceinline__ unsigned xb_add(unsigned* p, unsigned v) { return __hip_atomic_fetch_add(p, v, __ATOMIC_RELAXED, __HIP_MEMORY_SCOPE_AGENT); }
__device__ __forceinline__ unsigned xb_xcc_id() { return (unsigned)__builtin_amdgcn_s_getreg((3 << 11) | 20) & 0xFu; }
#define XB_SPIN(cond, bar) do { unsigned _sp = 0; while (cond) { __builtin_amdgcn_s_sleep(1); \
    if ((++_sp & 255u) == 0u) { if (xb_ld(&(bar)[XB_TMO])) break; if (_sp > XB_SPIN_CAP) { atomicAdd(&(bar)[XB_TMO], 1u); break; } } } } while (0)

struct XcdBarrier {
    unsigned* bar; unsigned x;
    volatile LAS unsigned* st;
};

__device__ __forceinline__ XcdBarrier xcd_barrier_post(unsigned* bar, volatile LAS unsigned* st) {
    XcdBarrier b; b.bar = bar; b.x = xb_xcc_id(); b.st = st;
    if (threadIdx.x == 0) (void)xb_add(&bar[XB_XCNT(b.x)], 1u);
    return b;
}
__device__ __forceinline__ void xcd_barrier_complete(unsigned* bar, unsigned x, unsigned& nloc, unsigned& nx) {
    const unsigned G = gridDim.x * gridDim.y * gridDim.z;
    unsigned sum, cnt, mine, sp = 0u;
    for (;;) {
        sum = 0u; cnt = 0u; mine = 0u;
#pragma unroll
        for (unsigned j = 0; j < 16; ++j) { const unsigned c = xb_ld(&bar[XB_XCNT(j)]); sum += c; cnt += (c > 0u) ? 1u : 0u; mine = (j == x) ? c : mine; }
        if (sum == G) break;
        __builtin_amdgcn_s_sleep(1);
        if ((++sp & 255u) == 0u) { if (xb_ld(&bar[XB_TMO])) break; if (sp > XB_SPIN_CAP) { atomicAdd(&bar[XB_TMO], 1u); break; } }
    }
    nloc = mine > 0u ? mine : 1u; nx = cnt > 0u ? cnt : 1u;
}

__device__ __forceinline__ void xcd_barrier(const XcdBarrier& b) {
    asm volatile("s_waitcnt vmcnt(0)" ::: "memory");
    __syncthreads();
    if (threadIdx.x == 0) {
        unsigned* bar = b.bar;
        __builtin_amdgcn_s_waitcnt(0);
        unsigned nloc = b.st[0], nx = b.st[1];
        if (nloc == 0u) { xcd_barrier_complete(bar, b.x, nloc, nx); b.st[0] = nloc; b.st[1] = nx; }
        const unsigned old = xb_add(&bar[XB_XSUB(b.x)], 1u);
        const unsigned gen = old / nloc;
        if (old + 1u == (gen + 1u) * nloc) {
            __builtin_amdgcn_fence(__ATOMIC_RELEASE, "agent");
            asm volatile("s_waitcnt vmcnt(0)" ::: "memory");
            const unsigned og = xb_add(&bar[XB_TOP], 1u);
            const unsigned tg = og / nx;
            if (og + 1u == (tg + 1u) * nx) xb_add(&bar[XB_TOPGEN], 1u);
            else XB_SPIN(xb_ld(&bar[XB_TOPGEN]) == tg, bar);
            __builtin_amdgcn_fence(__ATOMIC_ACQUIRE, "agent");
            xb_add(&bar[XB_XGEN(b.x)], 1u);
            asm volatile("s_waitcnt vmcnt(0)" ::: "memory");
        } else {
            XB_SPIN(xb_ld(&bar[XB_XGEN(b.x)]) == gen, bar);
            __builtin_amdgcn_fence(__ATOMIC_ACQUIRE, "agent");
            asm volatile("s_waitcnt vmcnt(0)" ::: "memory");
        }
    }
    __syncthreads();
}
typedef _Float16 f16;
typedef _Float16 h16x8 __attribute__((ext_vector_type(8)));
typedef _Float16 h16x4 __attribute__((ext_vector_type(4)));
typedef float f32x4 __attribute__((ext_vector_type(4)));
typedef unsigned u32x4 __attribute__((ext_vector_type(4)));
typedef unsigned u32x2 __attribute__((ext_vector_type(2)));
using pg8::pk2h; using pg8::silu_f; using pg8::sigm_f;

constexpr int NWAVES = 8, NTHR = 512;
constexpr int DMODEL = 1024, SEQ = 16384, CTX = 256, T = SEQ + CTX, DEPTH = 4, DFF = 2816, INW = 6400, NMOD = 9;
constexpr int WP = 2304;
constexpr int C_Q = 0, C_K = 512, C_V = 640, C_F = 768, C_CG = 1024, C_SC = 1536, C_G = 2304;
constexpr float EPS = 1e-6f;
constexpr float QSCALE = 0.125f * 1.4426950408889634f;
enum { I_X = 0, I_C, I_CTX, I_CCTX, I_WADA, I_BADA, I_NORMG, I_W13, I_W2, I_WIN, I_BGATE, I_QNG, I_KNG, I_WAO, I_WFN, I_CDW, I_CDB, I_CLG, I_CLB, I_WCO, I_SCW, I_WSO, I_WO, I_FNG, N_IN };

constexpr size_t MiB = 1u << 20;
constexpr size_t WS_MOD = 1 * MiB;
constexpr size_t WS_D1 = 2 * MiB;
constexpr size_t WS_D2 = WS_D1 + 65536;
constexpr size_t WS_DC = WS_D2 + 131072;
constexpr size_t WS_W = 4 * MiB;
constexpr size_t W13_E = (size_t)2 * DFF * DMODEL;
constexpr size_t W2_E = (size_t)DMODEL * DFF;
constexpr size_t OFF_W13 = 0, OFF_W2 = OFF_W13 + 2 * W13_E, OFF_WIN = OFF_W2 + 2 * W2_E, OFF_WA = OFF_WIN + (size_t)INW * DMODEL,
                 OFF_WF = OFF_WA + 1024 * 512, OFF_WC = OFF_WF + 1024 * 512, OFF_WS = OFF_WC + 1024 * 256, OFF_WO = OFF_WS + 1024 * 256, W_TOTAL_E = OFF_WO + 1024 * 1024;
constexpr size_t WS_X = 56 * MiB;
constexpr size_t WS_H = 122 * MiB;
constexpr size_t WS_MH = 155 * MiB;
constexpr size_t WS_WINB = 188 * MiB;
constexpr size_t WS_G8 = 280 * MiB;
constexpr size_t WS_M32 = 392 * MiB;
constexpr size_t WS_QB = 458 * MiB;
constexpr size_t WS_AO = 475 * MiB;
constexpr size_t WS_FO = 492 * MiB;
constexpr size_t WS_KB = 509 * MiB;
constexpr size_t WS_VB = 514 * MiB;
constexpr size_t WS_CV = 519 * MiB;
constexpr size_t WS_SCB = 528 * MiB;
constexpr size_t WS_AP = 537 * MiB;
constexpr size_t WS_PART = 554 * MiB;
constexpr size_t WS_END = 566 * MiB;
static_assert(WS_W + W_TOTAL_E * 2 <= WS_X && WS_X + (size_t)T * 1024 * 4 <= WS_H && WS_H + (size_t)T * 2048 <= WS_MH && WS_MH + (size_t)T * 2048 <= WS_WINB &&
              WS_WINB + (size_t)T * DFF * 2 <= WS_G8 && WS_WINB + (size_t)T * WP * 2 <= WS_G8 && WS_G8 + (size_t)T * 4096 <= WS_M32 && WS_M32 + (size_t)T * 4096 <= WS_QB && WS_QB + (size_t)T * 1024 <= WS_AO && WS_AO + (size_t)T * 1024 <= WS_FO &&
              WS_FO + (size_t)T * 1024 <= WS_KB && WS_KB + (size_t)T * 256 <= WS_VB && WS_VB + (size_t)T * 256 <= WS_CV && WS_CV + (size_t)T * 512 <= WS_SCB &&
              WS_SCB + (size_t)T * 512 <= WS_AP && W_TOTAL_E * 2 <= (size_t)T * 4096 && WS_AP + 16 * MiB <= WS_PART && WS_PART + (size_t)11 * 256 * 4096 <= WS_END, "d_ws map");
constexpr int LDS_BYTES = 147456;
constexpr int LDS_TAB = 143360;
constexpr int LDS_BARST = 143360 + 1024;
constexpr size_t WS_BAR = 0;

struct Args { const float* in[N_IN]; float* out; unsigned char* ws; };

__device__ __forceinline__ void sincos_turns(float t, float* sn, float* cs) { *sn = __builtin_amdgcn_sinf(t); *cs = __builtin_amdgcn_cosf(t); }
__device__ __forceinline__ float wave_sum(float v) {
#pragma unroll
    for (int o = 1; o < 64; o <<= 1) v += __shfl_xor(v, o);
    return v;
}

struct TItem { const float* W; f16* WT; int K, N, item, swz; };
__device__ __forceinline__ void titem_load(const TItem& d, f32x4 (&t)[8], int lane) {
    const int nblk = d.N / 32, kb = d.item / nblk, nb = d.item % nblk, k0 = 64 * kb, n0 = 32 * nb;
#pragma unroll
    for (int i = 0; i < 8; ++i) t[i] = *(const f32x4*)(d.W + (size_t)(k0 + 8 * i + (lane >> 3)) * d.N + n0 + 4 * (lane & 7));
}
__device__ __forceinline__ void titem_finish(const TItem& d, const f32x4 (&t)[8], LAS float* scr, int lane) {
    const int nblk = d.N / 32, kb = d.item / nblk, nb = d.item % nblk, k0 = 64 * kb, n0 = 32 * nb;
#pragma unroll
    for (int i = 0; i < 8; ++i) { LAS float* p = scr + (8 * i + (lane >> 3)) * 33 + 4 * (lane & 7); p[0] = t[i].x; p[1] = t[i].y; p[2] = t[i].z; p[3] = t[i].w; }
    asm volatile("s_waitcnt lgkmcnt(0)" ::: "memory");
    int r0 = n0;
    if (d.swz) { const int blk = n0 >> 7, within = n0 & 127; r0 = (blk < 22) ? (256 * blk + within) : (256 * (blk - 22) + 128 + within); }
    const int c = lane & 7;
#pragma unroll
    for (int j = 0; j < 4; ++j) { const int n = (lane >> 3) + 8 * j; const LAS float* s = scr + (8 * c) * 33 + n;
        u32x4 o; o.x = pk2h(s[0 * 33], s[1 * 33]); o.y = pk2h(s[2 * 33], s[3 * 33]); o.z = pk2h(s[4 * 33], s[5 * 33]); o.w = pk2h(s[6 * 33], s[7 * 33]);
        *(u32x4*)(d.WT + (size_t)(r0 + n) * d.K + k0 + 8 * c) = o; }
    asm volatile("s_waitcnt lgkmcnt(0)" ::: "memory");
}
constexpr int CVT_NITEMS = 2 * 16 * 176 + 2 * 44 * 32 + 16 * 200 + 8 * 32 + 2 * 4 * 32 + 16 * 32;
__device__ __forceinline__ TItem cvt_item(const KP& a, int l, f16* WB, int it) {
    constexpr int IT13 = 16 * 176, IT2 = 44 * 32, ITIN = 16 * 200, ITA = 8 * 32, ITC = 4 * 32;
    int r = it; TItem d;
    if (r < 2 * IT13) { const int s = r / IT13; d.W = a.in(I_W13) + (size_t)(l * 2 + s) * DMODEL * 2 * DFF; d.K = DMODEL; d.N = 2 * DFF; d.WT = WB + OFF_W13 + s * W13_E; d.swz = 1; d.item = r % IT13; return d; } r -= 2 * IT13;
    if (r < 2 * IT2) { const int s = r / IT2; d.W = a.in(I_W2) + (size_t)(l * 2 + s) * DFF * DMODEL; d.K = DFF; d.N = DMODEL; d.WT = WB + OFF_W2 + s * W2_E; d.swz = 0; d.item = r % IT2; return d; } r -= 2 * IT2;
    d.swz = 0; d.item = r;
    if (r < ITIN) { d.W = a.in(I_WIN) + (size_t)l * DMODEL * INW; d.K = DMODEL; d.N = INW; d.WT = WB + OFF_WIN; return d; } r -= ITIN; d.item = r;
    if (r < ITA) { d.W = a.in(I_WAO) + (size_t)l * 512 * 1024; d.K = 512; d.N = 1024; d.WT = WB + OFF_WA; return d; } r -= ITA; d.item = r;
    if (r < ITC) { d.W = a.in(I_WCO) + (size_t)l * 256 * 1024; d.K = 256; d.N = 1024; d.WT = WB + OFF_WC; return d; } r -= ITC; d.item = r;
    if (r < ITC) { d.W = a.in(I_WSO) + (size_t)l * 256 * 1024; d.K = 256; d.N = 1024; d.WT = WB + OFF_WS; return d; } r -= ITC; d.item = r;
    d.W = a.in(I_WO) + (size_t)l * 1024 * 1024; d.K = 1024; d.N = 1024; d.WT = WB + OFF_WO; return d;
}
__device__ __forceinline__ void convert_weights(const KP& a, int l, f16* WB, LAS unsigned char* lds, int widx, int nw, int it_lo, int it_hi, int ftid, int fnt, int wave, int lane) {
    LAS float* scr = (LAS float*)(lds + wave * 16384);
    {
        int it = it_lo + widx; TItem d0; f32x4 tA[8];
        if (it < it_hi) { d0 = cvt_item(a, l, WB, it); titem_load(d0, tA, lane); }
        for (; it < it_hi; it += nw) {
            const int itn = it + nw; TItem d1 = d0; f32x4 tB[8];
            if (itn < it_hi) { d1 = cvt_item(a, l, WB, itn); titem_load(d1, tB, lane); }
            titem_finish(d0, tA, scr, lane);
            d0 = d1;
#pragma unroll
            for (int i = 0; i < 8; ++i) tA[i] = tB[i];
        }
    }
    const LAS float* ctab = (const LAS float*)(lds + LDS_TAB); const LAS float* stab = ctab + 64;
    const float* wf = a.in(I_WFN) + (size_t)l * 256 * 1024;
    if (fnt > 0)
    for (int idx = ftid; idx < 65536; idx += fnt) {
        const int o = idx & 1023, rest = idx >> 10, j8 = rest & 7, g = (rest >> 3) & 3, part = rest >> 5;
        float acc[8];
#pragma unroll
        for (int i = 0; i < 8; ++i) acc[i] = 0.f;
        const LAS float* tab = part ? stab : ctab;
#pragma unroll 1
        for (int m0 = 0; m0 < 64; m0 += 16) { float wv[16];
#pragma unroll
            for (int mm = 0; mm < 16; ++mm) wv[mm] = wf[(size_t)(g * 64 + m0 + mm) * 1024 + o];
#pragma unroll
            for (int mm = 0; mm < 16; ++mm)
#pragma unroll
                for (int i = 0; i < 8; ++i) acc[i] += tab[((m0 + mm) * (j8 * 8 + i)) & 63] * wv[mm]; }
        u32x4 w; w.x = pk2h(acc[0] * 0.125f, acc[1] * 0.125f); w.y = pk2h(acc[2] * 0.125f, acc[3] * 0.125f); w.z = pk2h(acc[4] * 0.125f, acc[5] * 0.125f); w.w = pk2h(acc[6] * 0.125f, acc[7] * 0.125f);
        *(u32x4*)(WB + OFF_WF + (size_t)o * 512 + part * 256 + g * 64 + j8 * 8) = w;
    }
}
__device__ __forceinline__ void phase0(const KP& a, LAS unsigned char* lds, int gw, int NGW, int wave, int lane) {
    const int tid = fresh_tid();
    {
        LAS float* sl = (LAS float*)lds; LAS float* sc = sl + 1024; LAS float* red = sl + 2048;
        float* MOD = (float*)(a.ws() + WS_MOD);
        bool have = false;
        for (int u = blockIdx.x; u < DEPTH * 36; u += gridDim.x) {
            if (!have) { for (int k = tid; k < 1024; k += NTHR) { sl[k] = silu_f(a.in(I_C)[k]); sc[k] = silu_f(a.in(I_CCTX)[k]); } have = true; __syncthreads(); }
            const int l = u / 36, strip = u % 36;
            const float* wp = a.in(I_WADA) + ((size_t)l * 1024 + wave * 128) * 9216 + strip * 256 + 4 * lane;
            f32x4 a0 = {0.f, 0.f, 0.f, 0.f}, a1 = {0.f, 0.f, 0.f, 0.f};
#pragma unroll 8
            for (int k = 0; k < 128; ++k) { const f32x4 wv = *(const f32x4*)(wp + (size_t)k * 9216); a0 += sl[wave * 128 + k] * wv; a1 += sc[wave * 128 + k] * wv; }
            *(LAS f32x4*)(red + (wave * 2 + 0) * 256 + 4 * lane) = a0; *(LAS f32x4*)(red + (wave * 2 + 1) * 256 + 4 * lane) = a1;
            __syncthreads();
            { const int s = tid >> 8, c = tid & 255; float v = a.in(I_BADA)[l * 9216 + strip * 256 + c];
#pragma unroll
              for (int w = 0; w < 8; ++w) v += red[(w * 2 + s) * 256 + c];
              MOD[(size_t)(l * 2 + s) * 9216 + strip * 256 + c] = v; }
            __syncthreads();
        }
        __syncthreads();
    }
    const int gt = blockIdx.x * NTHR + tid, GT = gridDim.x * NTHR;
    { f16* D1 = (f16*)(a.ws() + WS_D1); f16* D2 = (f16*)(a.ws() + WS_D2); f16* DC = (f16*)(a.ws() + WS_DC);
      const float s128 = 0.08838834764831845f;
      for (int i = gt; i < 32768 + 65536 + 131072; i += GT) {
          float sn, cs;
          if (i < 32768) { const int r = i >> 7, n1 = i & 127, k1 = r & 127; sincos_turns((float)((k1 * n1) & 127) * (1.0f / 128.0f), &sn, &cs); D1[i] = (f16)((r < 128 ? cs : -sn) * s128); }
          else if (i < 32768 + 65536) { const int ii = i - 32768, r = ii >> 8, kk = ii & 255, k2 = r & 127, n2 = kk >> 1, p = kk & 1; sincos_turns((float)((k2 * n2) & 127) * (1.0f / 128.0f), &sn, &cs);
              const float v = (r < 128) ? (p ? sn : cs) : (p ? cs : -sn); D2[ii] = (f16)(v * s128); }
          else { const int ii = i - 32768 - 65536, h = ii >> 16, r = (ii >> 8) & 255, n = ii & 255, rt = r >> 7, k = 128 * h + (r & 127); sincos_turns((float)((k * n) & 255) * (1.0f / 256.0f), &sn, &cs);
              DC[ii] = (f16)((rt ? -sn : cs) * 0.0625f); }
      } }
    convert_weights(a, 0, (f16*)(a.ws() + WS_W), lds, gw, NGW, 0, CVT_NITEMS, gt, GT, wave, lane);
}

#define NORM_COL(k) (8 * lane + 512 * ((k) >> 1) + 4 * ((k) & 1))
__device__ __forceinline__ void ld_row16(const f16* p, int lane, f32x4 (&v)[4]) {
#pragma unroll
    for (int j = 0; j < 2; ++j) { const h16x8 hv = *(const h16x8*)(p + 8 * lane + 512 * j);
        v[2 * j] = (f32x4){(float)hv[0], (float)hv[1], (float)hv[2], (float)hv[3]}; v[2 * j + 1] = (f32x4){(float)hv[4], (float)hv[5], (float)hv[6], (float)hv[7]}; }
}
__device__ __forceinline__ void st_row16(f16* p, int lane, const f32x4 (&v)[4]) {
#pragma unroll
    for (int j = 0; j < 2; ++j) { u32x4 w; w.x = pk2h(v[2 * j].x, v[2 * j].y); w.y = pk2h(v[2 * j].z, v[2 * j].w); w.z = pk2h(v[2 * j + 1].x, v[2 * j + 1].y); w.w = pk2h(v[2 * j + 1].z, v[2 * j + 1].w);
        *(u32x4*)(p + 8 * lane + 512 * j) = w; }
}
template <bool FROM_INPUT> __device__ __forceinline__ void norm_phase(const KP& a, int l, int slot, int nslab, int gw, int NGW, int lane) {
    f16* X = (f16*)(a.ws() + WS_X); f16* H = (f16*)(a.ws() + WS_H); const float* PART = (const float*)(a.ws() + WS_PART);
    const float* g = a.in(I_NORMG) + (size_t)(l * 3 + slot) * 1024; const float* MOD = (const float*)(a.ws() + WS_MOD);
    const float* xin = a.in(I_X); const float* cin = a.in(I_CTX);
    for (int r0 = gw; r0 < T; r0 += 2 * NGW) {
        f32x4 v[2][4];
#pragma unroll
        for (int q = 0; q < 2; ++q) { const int r = r0 + q * NGW; if (r < T && !(nslab < 0 && r < CTX)) {
            if (FROM_INPUT) { const float* xr = (r < CTX ? cin + (size_t)r * 1024 : xin + (size_t)(r - CTX) * 1024);
#pragma unroll
                for (int k = 0; k < 4; ++k) v[q][k] = *(const f32x4*)(xr + NORM_COL(k)); }
            else ld_row16(X + (size_t)r * 1024, lane, v[q]); } }
#pragma unroll
        for (int q = 0; q < 2; ++q) { const int r = r0 + q * NGW; if (r < T && !(nslab < 0 && r < CTX)) {
            const float* md = MOD + (size_t)(l * 2 + (r < CTX ? 1 : 0)) * 9216; const float* shift = md + (3 * slot) * 1024; const float* scale = md + (3 * slot + 1) * 1024;
            if (FROM_INPUT) st_row16(X + (size_t)r * 1024, lane, v[q]);
            if (r < CTX && nslab > 0) {
                for (int s0 = 0; s0 < nslab; s0 += 4) { f32x4 pv[4][4];
#pragma unroll
                    for (int k4 = 0; k4 < 4; ++k4) { if (s0 + k4 < nslab) { const float* pr = PART + ((size_t)(s0 + k4) * 256 + r) * 1024;
#pragma unroll
                        for (int k = 0; k < 4; ++k) pv[k4][k] = *(const f32x4*)(pr + NORM_COL(k)); } }
#pragma unroll
                    for (int k4 = 0; k4 < 4; ++k4) { if (s0 + k4 < nslab) {
#pragma unroll
                        for (int k = 0; k < 4; ++k) v[q][k] += pv[k4][k]; } } }
                st_row16(X + (size_t)r * 1024, lane, v[q]); }
            float ss = 0.f;
#pragma unroll
            for (int k = 0; k < 4; ++k) ss += (v[q][k].x * v[q][k].x + v[q][k].y * v[q][k].y) + (v[q][k].z * v[q][k].z + v[q][k].w * v[q][k].w);
            const float rstd = 1.0f / sqrtf(wave_sum(ss) * (1.0f / 1024.0f) + EPS);
            f32x4 o[4];
#pragma unroll
            for (int k = 0; k < 4; ++k) { const int c = NORM_COL(k); const f32x4 gg = *(const f32x4*)(g + c), sc = *(const f32x4*)(scale + c), sh = *(const f32x4*)(shift + c);
                o[k] = (v[q][k] * rstd) * gg * (sc + 1.0f) + sh; }
            st_row16(H + (size_t)r * 1024, lane, o); } }
    }
}
__device__ __forceinline__ void final_norm(const KP& a, int gw, int NGW, int lane) {
    const f16* X = (const f16*)(a.ws() + WS_X) + (size_t)CTX * 1024; const float* g = a.in(I_FNG); float* out = a.out();
    for (int r0 = gw; r0 < SEQ; r0 += 2 * NGW) {
        f32x4 v[2][4];
#pragma unroll
        for (int q = 0; q < 2; ++q) { const int r = r0 + q * NGW; if (r < SEQ) ld_row16(X + (size_t)r * 1024, lane, v[q]); }
#pragma unroll
        for (int q = 0; q < 2; ++q) { const int r = r0 + q * NGW; if (r < SEQ) { float ss = 0.f;
#pragma unroll
            for (int k = 0; k < 4; ++k) ss += (v[q][k].x * v[q][k].x + v[q][k].y * v[q][k].y) + (v[q][k].z * v[q][k].z + v[q][k].w * v[q][k].w);
            const float rstd = 1.0f / sqrtf(wave_sum(ss) * (1.0f / 1024.0f) + EPS);
#pragma unroll
            for (int k = 0; k < 4; ++k) { const int c = NORM_COL(k); *(f32x4*)(out + (size_t)r * 1024 + c) = (v[q][k] * rstd) * *(const f32x4*)(g + c); } } }
    }
}

__device__ __forceinline__ void qkv_prep(const KP& a, int l, int gw, int NGW, int lane) {
    const f16* WINB = (const f16*)(a.ws() + WS_WINB); f16* QB = (f16*)(a.ws() + WS_QB); f16* KB = (f16*)(a.ws() + WS_KB); f16* VB = (f16*)(a.ws() + WS_VB);
    const int j = lane & 7;
    float gq[8], gk[8], invf[8];
#pragma unroll
    for (int i = 0; i < 8; ++i) { gq[i] = a.in(I_QNG)[l * 64 + j * 8 + i]; gk[i] = a.in(I_KNG)[l * 64 + j * 8 + i];
        invf[i] = exp2f(-(float)(8 * (j & 1) + i) * (13.287712379549449f / 16.0f)); }
    const bool p1 = (j >> 1) & 1;
#pragma unroll 2
    for (int r = gw; r < T; r += NGW) {
        const f16* wrow = WINB + (size_t)r * WP;
        float cs[8], sn[8];
        const bool lat = r >= CTX;
        if (lat) { const int n = r - CTX; const float pos = (float)((j >> 2) ? (n & 63) : (n >> 6));
#pragma unroll
            for (int i = 0; i < 8; ++i) { const float ang = pos * invf[i]; sincos_turns(ang * 0.15915494309189535f, &sn[i], &cs[i]); } }
        else {
#pragma unroll
            for (int i = 0; i < 8; ++i) { cs[i] = 1.f; sn[i] = 0.f; } }
        { const h16x8 qv = *(const h16x8*)(wrow + C_Q + lane * 8); float x[8]; float ss = 0.f;
#pragma unroll
          for (int i = 0; i < 8; ++i) { x[i] = (float)qv[i]; ss += x[i] * x[i]; }
          ss += __shfl_xor(ss, 1); ss += __shfl_xor(ss, 2); ss += __shfl_xor(ss, 4);
          const float rs = 1.0f / sqrtf(ss * (1.0f / 64.0f) + EPS);
          float y[8];
#pragma unroll
          for (int i = 0; i < 8; ++i) { x[i] = x[i] * rs * gq[i]; }
#pragma unroll
          for (int i = 0; i < 8; ++i) { const float xp = __shfl_xor(x[i], 2); y[i] = p1 ? (xp * sn[i] + x[i] * cs[i]) : (x[i] * cs[i] - xp * sn[i]); y[i] *= QSCALE; }
          u32x4 w; w.x = pk2h(y[0], y[1]); w.y = pk2h(y[2], y[3]); w.z = pk2h(y[4], y[5]); w.w = pk2h(y[6], y[7]);
          *(u32x4*)(QB + (size_t)r * 512 + lane * 8) = w; }
        { const int lk = lane & 15; const h16x8 kv = *(const h16x8*)(wrow + C_K + lk * 8); float x[8]; float ss = 0.f;
#pragma unroll
          for (int i = 0; i < 8; ++i) { x[i] = (float)kv[i]; ss += x[i] * x[i]; }
          ss += __shfl_xor(ss, 1); ss += __shfl_xor(ss, 2); ss += __shfl_xor(ss, 4);
          const float rs = 1.0f / sqrtf(ss * (1.0f / 64.0f) + EPS);
          float y[8];
#pragma unroll
          for (int i = 0; i < 8; ++i) { x[i] = x[i] * rs * gk[i]; }
#pragma unroll
          for (int i = 0; i < 8; ++i) { const float xp = __shfl_xor(x[i], 2); y[i] = p1 ? (xp * sn[i] + x[i] * cs[i]) : (x[i] * cs[i] - xp * sn[i]); }
          u32x4 w; w.x = pk2h(y[0], y[1]); w.y = pk2h(y[2], y[3]); w.z = pk2h(y[4], y[5]); w.w = pk2h(y[6], y[7]);
          if (lane < 16) *(u32x4*)(KB + (size_t)r * 128 + lane * 8) = w;
          else if (lane < 32) *(u32x4*)(VB + (size_t)r * 128 + (lane - 16) * 8) = *(const u32x4*)(wrow + C_V + (lane - 16) * 8); }
    }
}
__device__ __forceinline__ void conv_unit(const KP& a, int l, int u, LAS unsigned char* lds, int wave, int lane) {
    const int tid = fresh_tid();
    const f16* WINB = (const f16*)(a.ws() + WS_WINB); f16* CV = (f16*)(a.ws() + WS_CV); f16* SCB = (f16*)(a.ws() + WS_SCB);
    const int seq0 = (u < 4) ? 0 : CTX, seq1 = (u < 4) ? CTX : T, r0 = (u < 4) ? 64 * u : CTX + 64 * (u - 4);
    LAS f16* tile = (LAS f16*)lds;
    LAS float* co = (LAS float*)(lds + 49152);
    { h16x8 a1[6], a2[6];
#pragma unroll
      for (int it = 0; it < 6; ++it) { const int idx = tid + it * NTHR, lr = idx >> 5, c8 = idx & 31, r = r0 - 15 + lr;
          if (idx < 94 * 32 && r >= seq0 && r < seq1) { a1[it] = *(const h16x8*)(WINB + (size_t)r * WP + C_CG + c8 * 8); a2[it] = *(const h16x8*)(WINB + (size_t)r * WP + C_CG + 256 + c8 * 8); } }
#pragma unroll
      for (int it = 0; it < 6; ++it) { const int idx = tid + it * NTHR, lr = idx >> 5, c8 = idx & 31, r = r0 - 15 + lr;
          if (idx < 94 * 32) { h16x8 o;
#pragma unroll
              for (int i = 0; i < 8; ++i) o[i] = (f16)0.f;
              if (r >= seq0 && r < seq1) {
#pragma unroll
                  for (int i = 0; i < 8; ++i) o[i] = (f16)((float)a1[it][i] * sigm_f((float)a2[it][i])); }
              *(LAS h16x8*)(tile + lr * 256 + c8 * 8) = o; } } }
    __syncthreads();
    { const int c = tid & 255, half = tid >> 8; float w[31];
#pragma unroll
      for (int t = 0; t < 31; ++t) w[t] = a.in(I_CDW)[(size_t)(l * 31 + t) * 256 + c];
      const float bias = a.in(I_CDB)[l * 256 + c];
      float xin[62];
#pragma unroll
      for (int i = 0; i < 62; ++i) xin[i] = (float)tile[(half * 32 + i) * 256 + c];
#pragma unroll
      for (int o = 0; o < 32; ++o) { float acc = bias;
#pragma unroll
          for (int t = 0; t < 31; ++t) acc += xin[o + t] * w[t];
          co[(half * 32 + o) * 256 + c] = acc; } }
    __syncthreads();
    { const f32x4 lg = *(const f32x4*)(a.in(I_CLG) + l * 256 + 4 * lane), lb = *(const f32x4*)(a.in(I_CLB) + l * 256 + 4 * lane);
#pragma unroll 1
      for (int tt = 0; tt < 8; ++tt) { const int tok = wave * 8 + tt; const f32x4 v = *(const LAS f32x4*)(co + tok * 256 + 4 * lane);
          const float mean = wave_sum((v.x + v.y) + (v.z + v.w)) * (1.0f / 256.0f); const f32x4 d = v - mean;
          const float var = wave_sum((d.x * d.x + d.y * d.y) + (d.z * d.z + d.w * d.w)) * (1.0f / 256.0f); const float rstd = 1.0f / sqrtf(var + EPS);
          f32x4 y = d * rstd * lg + lb; y.x = silu_f(y.x); y.y = silu_f(y.y); y.z = silu_f(y.z); y.w = silu_f(y.w);
          u32x2 w; w.x = pk2h(y.x, y.y); w.y = pk2h(y.z, y.w); *(u32x2*)(CV + (size_t)(r0 + tok) * 256 + 4 * lane) = w; } }
    for (int idx = tid; idx < 64 * 32; idx += NTHR) { const int lr = idx >> 5, c8 = idx & 31, r = r0 + lr; float acc[8];
#pragma unroll
        for (int i = 0; i < 8; ++i) acc[i] = 0.f;
#pragma unroll
        for (int t = 0; t < 3; ++t) { const int rr = r + t - 1; if (rr >= seq0 && rr < seq1) {
            const h16x8 gc = *(const h16x8*)(WINB + (size_t)rr * WP + C_SC + 256 + c8 * 8), hh = *(const h16x8*)(WINB + (size_t)rr * WP + C_SC + 512 + c8 * 8);
            const float* wp = a.in(I_SCW) + (size_t)(l * 3 + t) * 256 + c8 * 8;
#pragma unroll
            for (int i = 0; i < 8; ++i) acc[i] += (float)gc[i] * (float)hh[i] * wp[i]; } }
        const h16x8 gb = *(const h16x8*)(WINB + (size_t)r * WP + C_SC + c8 * 8);
        u32x4 w; w.x = pk2h((float)gb[0] * acc[0], (float)gb[1] * acc[1]); w.y = pk2h((float)gb[2] * acc[2], (float)gb[3] * acc[3]);
        w.z = pk2h((float)gb[4] * acc[4], (float)gb[5] * acc[5]); w.w = pk2h((float)gb[6] * acc[6], (float)gb[7] * acc[7]);
        *(u32x4*)(SCB + (size_t)r * 256 + c8 * 8) = w; }
    __syncthreads();
}
template <int K, int NCT, class Epi>
__device__ __forceinline__ void dft_unit(LAS unsigned char* lds, const f16* gsrc, size_t rstride, const f16* Dm, int ch0, const Epi& E) {
    constexpr int LPB = 516;
    const int tid = fresh_tid(), lane = tid & 63, wave = tid >> 6, fr = lane & 15, fq = lane >> 4;
    { constexpr int NIT = K * 16 * NCT / NTHR; u32x4 sv[NIT];
#pragma unroll
      for (int it = 0; it < NIT; ++it) { const int i = tid + it * NTHR, row = i / (16 * NCT), pc = i % (16 * NCT); sv[it] = *(const u32x4*)(gsrc + (size_t)row * rstride + ch0 + pc * 8); }
#pragma unroll
      for (int it = 0; it < NIT; ++it) { const int i = tid + it * NTHR, row = i / (16 * NCT), pc = i % (16 * NCT);
          LAS unsigned* d = (LAS unsigned*)(lds + row * LPB + pc * 16); d[0] = sv[it].x; d[1] = sv[it].y; d[2] = sv[it].z; d[3] = sv[it].w; } }
    __syncthreads();
    const int cbase = wave * 16 * NCT;
    h16x8 df[NCT][K / 32];
#pragma unroll
    for (int ct = 0; ct < NCT; ++ct)
#pragma unroll
        for (int ks = 0; ks < K / 32; ++ks)
#pragma unroll
            for (int e = 0; e < 8; ++e) df[ct][ks][e] = *(const LAS f16*)(lds + (ks * 32 + fq * 8 + e) * LPB + (cbase + ct * 16 + fr) * 2);
    h16x8 dm[2][2][K / 32];
#define DFT_LOAD_DM(buf, jj) do { _Pragma("unroll") for (int rt = 0; rt < 2; ++rt) _Pragma("unroll") for (int ks = 0; ks < K / 32; ++ks) \
        dm[buf][rt][ks] = *(const h16x8*)(Dm + (size_t)(rt * 128 + (jj) * 16 + fr) * K + ks * 32 + fq * 8); } while (0)
    DFT_LOAD_DM(0, 0);
#pragma unroll
    for (int j = 0; j < 8; ++j) {
        if (j + 1 < 8) DFT_LOAD_DM((j + 1) & 1, j + 1);
        f32x4 acc[2][NCT];
#pragma unroll
        for (int rt = 0; rt < 2; ++rt)
#pragma unroll
            for (int ct = 0; ct < NCT; ++ct) acc[rt][ct] = (f32x4){0.f, 0.f, 0.f, 0.f};
#pragma unroll
        for (int rt = 0; rt < 2; ++rt)
#pragma unroll
            for (int ks = 0; ks < K / 32; ++ks)
#pragma unroll
                for (int ct = 0; ct < NCT; ++ct) acc[rt][ct] = __builtin_amdgcn_mfma_f32_16x16x32_f16(df[ct][ks], dm[j & 1][rt][ks], acc[rt][ct], 0, 0, 0);
#pragma unroll
        for (int ct = 0; ct < NCT; ++ct) E(j * 16 + fr, ch0 + cbase + ct * 16 + 4 * fq, acc[0][ct], acc[1][ct]);
    }
#undef DFT_LOAD_DM
    __syncthreads();
}
__device__ __forceinline__ void st4h(f16* p, f32x4 v) { u32x2 w; w.x = pk2h(v.x, v.y); w.y = pk2h(v.z, v.w); *(u32x2*)p = w; }
struct EpiB1 { f16* AP; int n2;
    __device__ __forceinline__ void operator()(int k1, int c, f32x4 re, f32x4 im) const {
        float sn, cs; sincos_turns((float)((k1 * n2) & 16383) * (1.0f / 16384.0f), &sn, &cs);
        const f32x4 ar = re * cs + im * sn, ai = im * cs - re * sn;
        f16* p = AP + ((size_t)(k1 * 128 + n2) * 2) * 256 + c; st4h(p, ar); st4h(p + 256, ai); } };
struct EpiB2 { f16* FO; int k1;
    __device__ __forceinline__ void operator()(int k2, int c, f32x4 re, f32x4 im) const {
        f16* p = FO + (size_t)(CTX + k1 + 128 * k2) * 512 + c; st4h(p, re); st4h(p + 256, im); } };
struct EpiDC { f16* FO; int h;
    __device__ __forceinline__ void operator()(int kk, int c, f32x4 re, f32x4 im) const {
        f16* p = FO + (size_t)(128 * h + kk) * 512 + c; st4h(p, re); st4h(p + 256, im); } };

template <class Epi> __device__ __forceinline__ void run_gemm(LAS unsigned char* lds, const f16* A, const f16* Bt, int M, int N, int K, const Epi& E) {
    pg8::Gemm g{(const pg8::bf16_t*)A, (const pg8::bf16_t*)Bt, M, N, K}; pg8::StaticOrder S; S.init(M, N, (int)gridDim.x, (int)blockIdx.x); S.nt0 = K / pg8::BK;
    pg8::gemm_phase<Epi, pg8::StaticOrder, true, true>(lds, g, S, E);
}

template <class Epi> __device__ __forceinline__ void run_gemm_ctx(LAS unsigned char* lds, const f16* A, const f16* Bt, int K, int S, int coff, const Epi& E) {
    pg8::Gemm g{(const pg8::bf16_t*)A, (const pg8::bf16_t*)Bt, T, DMODEL, K}; pg8::CtxSplitOrder O; O.init(K, S, (int)gridDim.x, (int)blockIdx.x, coff);
    pg8::gemm_phase<Epi, pg8::CtxSplitOrder, true, true>(lds, g, O, E);
}
#ifndef REP_MIX
#define REP_MIX 1
#endif
#ifndef REP_GEMM
#define REP_GEMM 1
#endif
#ifndef REP_LIGHT
#define REP_LIGHT 1
#endif
#ifndef REP_P0
#define REP_P0 1
#endif
#ifndef REP_QKV
#define REP_QKV 1
#endif
#ifndef REP_BAR
#define REP_BAR 1
#endif
#ifdef AMP_CLS
#define TMARK(cls) do { const unsigned now_ = (unsigned)__builtin_amdgcn_s_memrealtime(); const unsigned d_ = now_ - t_last; \
    if ((cls) == AMP_CLS && blockIdx.x == 0) { const unsigned until_ = now_ + AMP_MUL * d_; while ((int)((unsigned)__builtin_amdgcn_s_memrealtime() - until_) < 0) __builtin_amdgcn_s_sleep(8); } \
    t_last = (unsigned)__builtin_amdgcn_s_memrealtime(); } while (0)
#elif defined(PROBE_T)
#define TMARK(cls) do { const unsigned now_ = (unsigned)__builtin_amdgcn_s_memrealtime(); const unsigned d_ = now_ - t_last; t_last = now_; if ((cls) == PROBE_A) tA += d_; if ((cls) == PROBE_B) tB += d_; } while (0)
#else
#define TMARK(cls) do {} while (0)
#endif
#define TAIL_CONVERT(nwg, lo, hi, with_fnet) do { if (l + 1 < DEPTH) { const int rounds_ = ((nwg) + G - 1) / G, busy_ = (nwg) - (rounds_ - 1) * G, idle_ = G - busy_; \
    if (idle_ == 0) convert_weights(a, l + 1, (f16*)(ws + wbnext), lds, gw, NGW, (lo), (hi), (with_fnet) ? gw * 64 + lane : 0, (with_fnet) ? NGW * 64 : 0, wave, lane); \
    else if (bx >= busy_) { const int widx_ = (bx - busy_) * NWAVES + wave, nw_ = idle_ * NWAVES; \
        convert_weights(a, l + 1, (f16*)(ws + wbnext), lds, widx_, nw_, (lo), (hi), (with_fnet) ? widx_ * 64 + lane : 0, (with_fnet) ? nw_ * 64 : 0, wave, lane); } } } while (0)
#define FRESH() const KP a = fresh_kp(); const int tid = fresh_tid(); const int lane = tid & 63; const int wave = __builtin_amdgcn_readfirstlane(tid >> 6); \
    const int gw = bx * NWAVES + wave; unsigned char* const ws = a.ws(); (void)lane; (void)gw; (void)ws
#define XBAR() do { for (int rb_ = 0; rb_ < REP_BAR; ++rb_) xcd_barrier(xbar); } while (0)
__global__ void __launch_bounds__(NTHR, 2) fwd_megakernel(Args a_unused) {
    extern __shared__ __attribute__((aligned(16))) unsigned char lds_raw[];
    cg::grid_group grid = cg::this_grid();
    LAS unsigned char* lds = (LAS unsigned char*)lds_raw;
    const int G = gridDim.x, bx = blockIdx.x;
    const int vcu = (G % 8 == 0) ? (bx % 8) * (G / 8) + bx / 8 : bx;
    const int NGW = G * NWAVES;
#ifdef AMP_CLS
    unsigned t_last = (unsigned)__builtin_amdgcn_s_memrealtime();
#elif defined(PROBE_T)
    unsigned tA = 0, tB = 0, t_last = (unsigned)__builtin_amdgcn_s_memrealtime();
#endif
    {
        FRESH();
        if (tid < 64) { float sn, cs; sincos_turns((float)tid * (1.0f / 64.0f), &sn, &cs); LAS float* ctab = (LAS float*)(lds + LDS_TAB); ctab[tid] = cs; ctab[64 + tid] = sn; }
        if (tid < 2) ((LAS unsigned*)(lds + LDS_BARST))[tid] = 0u;
        if (bx == 0) for (int i = tid; i < XCD_BAR_WORDS; i += NTHR) ((unsigned*)(ws + WS_BAR))[i] = 0u;
        __syncthreads();
#ifndef NO_P0
        for (int rep = 0; rep < REP_P0; ++rep) phase0(a, lds, gw, NGW, wave, lane);
#endif
    }
    grid.sync(); TMARK(0);
    XcdBarrier xbar;
    { FRESH(); xbar = xcd_barrier_post((unsigned*)(ws + WS_BAR), (volatile LAS unsigned*)(lds + LDS_BARST)); }


#pragma unroll 1
    for (int l = 0; l < DEPTH; ++l) {
        const bool lastl = (l == DEPTH - 1);
        const size_t wboff = (l & 1) ? WS_M32 : WS_W, wbnext = (l & 1) ? WS_W : WS_M32;
#pragma unroll 1
        for (int half = 0; half < 2; ++half) {
            const int slot = 2 * half;
            {
                FRESH();
                if (l == 0 && half == 0) norm_phase<true>(a, 0, 0, 0, gw, NGW, lane);
                else norm_phase<false>(a, l, slot, (half == 1) ? (lastl ? -1 : 4) : 11, gw, NGW, lane);
            }
            XBAR(); TMARK(1);
#ifndef NO_G1
            {
                FRESH();
#pragma unroll 1
                for (int rep = 0; rep < REP_GEMM; ++rep) {
                pg8::EpiSwiGLU E{(pg8::bf16_t*)(ws + WS_WINB), DFF};
                run_gemm(lds, (const f16*)(ws + WS_H), (const f16*)(ws + wboff) + OFF_W13 + half * W13_E, T, 2 * DFF, DMODEL, E); }
                if (half == 0) TAIL_CONVERT(65 * 22, 0, 3850, false); else TAIL_CONVERT(65 * 22, 8800, CVT_NITEMS, false);
            }
#endif
            XBAR(); TMARK(2);
#ifndef NO_G2
            {
                FRESH();
                const float* MOD = (const float*)(ws + WS_MOD);
#pragma unroll 1
                for (int rep = 0; rep < REP_GEMM; ++rep) {
                pg8::EpiResidual E{(pg8::bf16_t*)(ws + WS_X), MOD + (size_t)(l * 2 + 0) * 9216 + (3 * slot + 2) * 1024, MOD + (size_t)(l * 2 + 1) * 9216 + (3 * slot + 2) * 1024, (float*)(ws + WS_PART), rep ? 0.0f : 0.5f};
                run_gemm_ctx(lds, (const f16*)(ws + WS_WINB), (const f16*)(ws + wboff) + OFF_W2 + half * W2_E, DFF, 11, (lastl && half == 1) ? (1 << 20) : 0, E); }
            }
#endif
            XBAR(); TMARK(3);
            if (half == 1) break;
            {
                FRESH();
                norm_phase<false>(a, l, 1, 11, gw, NGW, lane);
            }
            XBAR(); TMARK(4);
#ifndef NO_G3
            {
                FRESH();
#pragma unroll 1
                for (int rep = 0; rep < REP_GEMM; ++rep) {
                pg8::EpiStoreF16 E{(pg8::bf16_t*)(ws + WS_WINB), WP, (unsigned char*)(ws + WS_G8), a.in(I_BGATE) + (size_t)l * 4096};
                run_gemm(lds, (const f16*)(ws + WS_H), (const f16*)(ws + wboff) + OFF_WIN, T, INW, DMODEL, E); }
                TAIL_CONVERT(65 * 25, 3850, 8800, true);
            }
#endif
            XBAR(); TMARK(5);
#pragma unroll 1
            for (int rep = 0; rep < REP_LIGHT; ++rep)
#pragma unroll 1
            for (int u = bx; u < 256 + 128 + 4 + 4; u += G) {
                FRESH();
                const f16* WINB = (const f16*)(ws + WS_WINB);
#ifndef NO_CONV
                if (u < 256) conv_unit(a, l, u + 4, lds, wave, lane); else if (u >= 388) conv_unit(a, l, u - 388, lds, wave, lane); else
#endif
#ifndef NO_DFT
                if (u < 384) { const int n2 = u - 256; EpiB1 E{(f16*)(ws + WS_AP), n2}; dft_unit<128, 2>(lds, WINB + (size_t)(CTX + n2) * WP + C_F, (size_t)128 * WP, (const f16*)(ws + WS_D1), 0, E); }
                else if (u < 388) { const int h = (u - 384) >> 1, chh = (u - 384) & 1; EpiDC E{(f16*)(ws + WS_FO), h}; dft_unit<256, 1>(lds, WINB + C_F, (size_t)WP, (const f16*)(ws + WS_DC) + (size_t)h * 65536, 128 * chh, E); }
#endif
                {}
            }
#ifndef NO_QKV
            {
                FRESH();
                for (int rep = 0; rep < REP_QKV; ++rep) qkv_prep(a, l, gw, NGW, lane);
            }
#endif
            XBAR(); TMARK(6);
#pragma unroll 1
            for (int rep = 0; rep < REP_MIX; ++rep)
#pragma unroll 1
            for (int idx = vcu; idx < 512 + 8 + 256; idx += G) {
                FRESH();
                const attn_body::bf16* QB = (const attn_body::bf16*)(ws + WS_QB); const attn_body::bf16* KB = (const attn_body::bf16*)(ws + WS_KB); const attn_body::bf16* VB = (const attn_body::bf16*)(ws + WS_VB);
                attn_body::bf16* AO = (attn_body::bf16*)(ws + WS_AO);
#ifndef NO_ATTN
                if (idx < 512) { const int v = idx & 255; attn_body::attn_unit<8>(v >> 5, 1 + 2 * (v & 31) + (idx >> 8), T / 64, QB, KB, VB, AO, (char*)lds_raw); }
                else if (idx < 520) { if (!lastl) attn_body::attn_unit<8>(idx - 512, 0, CTX / 64, QB, KB, VB, AO, (char*)lds_raw); }
                else
#endif
#ifndef NO_DFT2
                { const int k1 = (idx - 520) >> 1, chh = (idx - 520) & 1; EpiB2 E{(f16*)(ws + WS_FO), k1}; dft_unit<256, 1>(lds, (const f16*)(ws + WS_AP) + (size_t)k1 * 65536, (size_t)256, (const f16*)(ws + WS_D2), 128 * chh, E); }
#endif
                {}
            }
            XBAR(); TMARK(7);
#ifndef NO_G4
#pragma unroll 1
            for (int b = 0; b < 4 * REP_GEMM; ++b) {
                FRESH();
                const int b4 = b & 3; const f16* Ab = (const f16*)(ws + ((b4 == 0) ? WS_AO : (b4 == 1) ? WS_FO : (b4 == 2) ? WS_CV : WS_SCB));
                const f16* Wb = (const f16*)(ws + wboff) + ((b4 == 0) ? OFF_WA : (b4 == 1) ? OFF_WF : (b4 == 2) ? OFF_WC : OFF_WS);
                const int Kb = (b4 < 2) ? 512 : 256;
                pg8::EpiGate E{(const unsigned char*)(ws + WS_G8) + b4 * 1024, 4096, (float*)(ws + WS_M32), (pg8::bf16_t*)(ws + WS_MH), (float*)(ws + WS_PART) + (size_t)b4 * 256 * 1024, (b & 3) == 0, (b & 3) == 3};
                run_gemm_ctx(lds, Ab, Wb, Kb, 1, lastl ? (1 << 20) : 4 * b4, E);
            }
#endif
            XBAR(); TMARK(8);
            {
                FRESH();
                if (gw < CTX && !lastl) { const float* P = (const float*)(ws + WS_PART) + (size_t)gw * 1024; u32x2* o8 = (u32x2*)((f16*)(ws + WS_MH) + (size_t)gw * 1024) + lane;
#pragma unroll
                    for (int j = 0; j < 4; ++j) { f32x4 v = ((const f32x4*)P)[lane + 64 * j];
#pragma unroll
                        for (int s = 1; s < 4; ++s) v += ((const f32x4*)(P + (size_t)s * 256 * 1024))[lane + 64 * j];
                        u32x2 w; w.x = pk2h(v.x, v.y); w.y = pk2h(v.z, v.w); o8[64 * j] = w; } }
            }
            XBAR(); TMARK(11);
#ifndef NO_G5
            {
                FRESH();
                const float* MOD = (const float*)(ws + WS_MOD);
#pragma unroll 1
                for (int rep = 0; rep < REP_GEMM; ++rep) {
                pg8::EpiResidual E{(pg8::bf16_t*)(ws + WS_X), MOD + (size_t)(l * 2 + 0) * 9216 + 5 * 1024, MOD + (size_t)(l * 2 + 1) * 9216 + 5 * 1024, (float*)(ws + WS_PART), rep ? 0.0f : 1.0f};
                run_gemm_ctx(lds, (const f16*)(ws + WS_MH), (const f16*)(ws + wboff) + OFF_WO, DMODEL, 4, lastl ? (1 << 20) : 0, E); }
            }
#endif
            XBAR(); TMARK(9);
        }
    }
    {
        FRESH();
        final_norm(a, gw, NGW, lane);
    }
#ifdef PROBE_T
    XBAR(); TMARK(10);
    if (bx == 0) { FRESH(); float* o = a.out(); const float A = (float)tA * 0.01f, B = (float)tB * (0.01f / 16.0f);
        for (int i = tid; i <= 65536; i += NTHR) o[i] = (i == 0) ? A : B; }
#endif
}

extern "C" void kernel_launch(void* const* d_in, const int* in_sizes, int n_in, void* d_out, int out_size, void* d_ws, size_t ws_size, hipStream_t stream) {
    static int grid = 0;
    if (grid == 0) {
        if (n_in != N_IN || out_size != SEQ * DMODEL || ws_size < WS_END) { fprintf(stderr, "kernel_launch: unexpected shapes (n_in %d out %d ws %zu)\n", n_in, out_size, ws_size); grid = -1; return; }
        int dev = 0, cus = 0, per_cu = 0;
        if (hipGetDevice(&dev) != hipSuccess || hipDeviceGetAttribute(&cus, hipDeviceAttributeMultiprocessorCount, dev) != hipSuccess) { grid = -1; return; }
        if (hipFuncSetAttribute((const void*)fwd_megakernel, hipFuncAttributeMaxDynamicSharedMemorySize, LDS_BYTES) != hipSuccess) { fprintf(stderr, "kernel_launch: hipFuncSetAttribute failed\n"); grid = -1; return; }
        if (hipOccupancyMaxActiveBlocksPerMultiprocessor(&per_cu, (const void*)fwd_megakernel, NTHR, LDS_BYTES) != hipSuccess || per_cu < 1) { fprintf(stderr, "kernel_launch: occupancy query says %d\n", per_cu); per_cu = 1; }
        (void)hipGetLastError();
        grid = cus * per_cu;
    }
    if (grid < 0) return;
    Args a{};
    for (int i = 0; i < N_IN; ++i) a.in[i] = (const float*)d_in[i];
    a.out = (float*)d_out; a.ws = (unsigned char*)d_ws;
    void* args[] = {&a};
    hipError_t e = hipLaunchCooperativeKernel((const void*)fwd_megakernel, dim3(grid), dim3(NTHR), args, LDS_BYTES, stream);
    if (e != hipSuccess) fprintf(stderr, "kernel_launch: cooperative launch failed: %s (grid %d)\n", hipGetErrorString(e), grid);
}
```
